# Optimizing an MI355X kernel written in HIP

```python
import math
import jax, jax.numpy as jnp
from jax import lax
import numpy as np

D_MODEL = 1024
BATCH = 1
SEQ = 16384
DEPTH = 2
DEC_BATCH = 8
DEC_SEQ = 32
PAST_LEN = 1024

CHUNK = 64
EPS = 1e-6
LRU_W = D_MODEL // 2
LRU_HEADS = 8
LRU_HD = LRU_W // LRU_HEADS
CONV_W = 4
LRU_C = 8.0
SSM_W = D_MODEL - LRU_W
SSM_H = 16
SSM_G = SSM_W // SSM_H
SSM_P = 64
MIX_W = LRU_W + SSM_W
IN_W = 2 * LRU_W + SSM_W
D_FF = -(-8 * D_MODEL // (3 * 256)) * 256

kernel_name = "hymba_rglru_s5_streaming_step"


def _rmsnorm(x, g):
    xf = x.astype(jnp.float32)
    var = jnp.mean(xf * xf, axis=-1, keepdims=True)
    return (xf * lax.rsqrt(var + EPS) * g.astype(jnp.float32)).astype(x.dtype)


def _causal_conv(x, buf, w, b):
    T = x.shape[1]
    xp = jnp.concatenate([buf.astype(x.dtype), x], axis=1)
    y = b.astype(x.dtype)
    for k in range(CONV_W):
        y = y + xp[:, k:k + T] * w[k].astype(x.dtype)
    return y, xp[:, T:]


def _lin_combine(e1, e2):
    a1, b1 = e1
    a2, b2 = e2
    return (a1 * a2, a2 * b1 + b2)


def _rglru(xc, h0, wa, ba, wx, bx, lam):
    B_, T, W = xc.shape
    xf = xc.astype(jnp.float32)
    xh = xf.reshape(B_, T, LRU_HEADS, LRU_HD)
    r = jax.nn.sigmoid(jnp.einsum('bthi,hij->bthj', xh, wa.astype(jnp.float32)).reshape(B_, T, W) + ba.astype(jnp.float32))
    ig = jax.nn.sigmoid(jnp.einsum('bthi,hij->bthj', xh, wx.astype(jnp.float32)).reshape(B_, T, W) + bx.astype(jnp.float32))
    log_a = -LRU_C * r * jax.nn.softplus(-lam.astype(jnp.float32))
    a = jnp.exp(log_a)
    b = jnp.sqrt(-jnp.expm1(2.0 * log_a)) * (ig * xf)
    b = b.at[:, 0].add(a[:, 0] * h0.astype(jnp.float32))
    _, h = lax.associative_scan(_lin_combine, (a, b), axis=1)
    return h, h[:, -1]


def _cplx_combine(e1, e2):
    a1r, a1i, b1r, b1i = e1
    a2r, a2i, b2r, b2i = e2
    return (a2r * a1r - a2i * a1i, a2r * a1i + a2i * a1r,
            a2r * b1r - a2i * b1i + b2r, a2r * b1i + a2i * b1r + b2i)


def _s5(u, h_re, h_im, lam_re, lam_im, b_re, b_im, c_re, c_im, d, log_dt):
    B_, T, _ = u.shape
    f32 = jnp.float32
    uf = u.astype(f32)
    lr, li = lam_re.astype(f32), lam_im.astype(f32)
    dt = jnp.exp(log_dt.astype(f32))[:, None]
    mag = jnp.exp(lr * dt)
    lbr, lbi = mag * jnp.cos(li * dt), mag * jnp.sin(li * dt)
    nr, ni = lbr - 1.0, lbi
    den = lr * lr + li * li
    gr, gi = (nr * lr + ni * li) / den, (ni * lr - nr * li) / den
    br, bi = b_re.astype(f32), b_im.astype(f32)
    bbr = gr[..., None] * br - gi[..., None] * bi
    bbi = gr[..., None] * bi + gi[..., None] * br
    cr, ci = c_re.astype(f32), c_im.astype(f32)
    blk = CHUNK if T >= CHUNK else T
    n = T // blk
    uc = uf.reshape(B_, n, blk, SSM_G, SSM_H).transpose(1, 0, 2, 3, 4)

    def step(carry, u_blk):
        hr, hi = carry
        bur = jnp.einsum('blgh,gph->blgp', u_blk, bbr)
        bui = jnp.einsum('blgh,gph->blgp', u_blk, bbi)
        bur = bur.at[:, 0].add(lbr * hr - lbi * hi)
        bui = bui.at[:, 0].add(lbr * hi + lbi * hr)
        ar = jnp.broadcast_to(lbr, bur.shape)
        ai = jnp.broadcast_to(lbi, bui.shape)
        _, _, xr, xi = lax.associative_scan(_cplx_combine, (ar, ai, bur, bui), axis=1)
        y = jnp.einsum('ghp,blgp->blgh', cr, xr) - jnp.einsum('ghp,blgp->blgh', ci, xi)
        return (xr[:, -1], xi[:, -1]), y

    (hr, hi), ys = lax.scan(step, (h_re.astype(f32), h_im.astype(f32)), uc)
    y = ys.transpose(1, 0, 2, 3, 4).reshape(B_, T, SSM_W) + d.astype(f32) * uf
    return y, hr, hi


def _layer(x, conv_buf, lru_h, ssm_re, ssm_im, p):
    dt = x.dtype
    h = _rmsnorm(x, p['norm_mix'])
    z = jnp.einsum('btd,de->bte', h, p['w_in'])
    xl = z[..., :LRU_W]
    gl = z[..., LRU_W:2 * LRU_W]
    us = z[..., 2 * LRU_W:]
    xc, new_conv = _causal_conv(xl, conv_buf, p['conv_w'], p['conv_b'])
    hl, new_lru = _rglru(xc, lru_h, p['lru_wa'], p['lru_ba'], p['lru_wx'], p['lru_bx'], p['lru_lambda'])
    y_lru = (hl * jax.nn.gelu(gl.astype(jnp.float32))).astype(dt)
    ys, new_re, new_im = _s5(us, ssm_re, ssm_im, p['ssm_lambda_re'], p['ssm_lambda_im'], p['ssm_b_re'], p['ssm_b_im'],
                             p['ssm_c_re'], p['ssm_c_im'], p['ssm_d'], p['ssm_log_dt'])
    g = jax.nn.gelu(ys)
    y_ssm = (g * jax.nn.sigmoid(jnp.einsum('bte,ef->btf', g, p['ssm_w_glu'].astype(jnp.float32)) + p['ssm_b_glu'].astype(jnp.float32))).astype(dt)
    mix = jnp.concatenate([_rmsnorm(y_lru, p['norm_lru_out']), _rmsnorm(y_ssm, p['norm_ssm_out'])], axis=-1)
    x = x + jnp.einsum('bte,ed->btd', mix, p['w_out'])
    h2 = _rmsnorm(x, p['norm_ffn'])
    ff = jax.nn.silu(jnp.einsum('btd,df->btf', h2, p['w_gate'])) * jnp.einsum('btd,df->btf', h2, p['w_up'])
    x = x + jnp.einsum('btf,fd->btd', ff, p['w_down'])
    return x, new_conv, new_lru, new_re, new_im


def setup_inputs(seed: int = 0) -> dict:
    key = jax.random.key(seed)
    ks = jax.random.split(key, 40)
    f32 = jnp.float32

    def nrm(k, shape, scale):
        return jax.random.normal(k, shape, f32) * scale

    def gain(k, shape):
        return 1.0 + 0.02 * jax.random.normal(k, shape, f32)

    a0 = jax.random.uniform(ks[14], (DEPTH, LRU_W), f32, 0.9, 0.999)
    lam_im_base = jnp.pi * jnp.arange(SSM_P, dtype=f32)
    return {
        "x_prompt": nrm(ks[0], (BATCH, SEQ, D_MODEL), 1.0),
        "x_sample": nrm(ks[1], (DEC_BATCH, DEC_SEQ, D_MODEL), 1.0),
        "state_conv": nrm(ks[2], (DEPTH, DEC_BATCH, CONV_W - 1, LRU_W), 1.0),
        "state_lru": nrm(ks[3], (DEPTH, DEC_BATCH, LRU_W), 0.5),
        "state_ssm_re": nrm(ks[4], (DEPTH, DEC_BATCH, SSM_G, SSM_P), 0.5),
        "state_ssm_im": nrm(ks[5], (DEPTH, DEC_BATCH, SSM_G, SSM_P), 0.5),
        "norm_mix": gain(ks[6], (DEPTH, D_MODEL)),
        "w_in": nrm(ks[7], (DEPTH, D_MODEL, IN_W), D_MODEL ** -0.5),
        "conv_w": nrm(ks[8], (DEPTH, CONV_W, LRU_W), CONV_W ** -0.5),
        "conv_b": nrm(ks[9], (DEPTH, LRU_W), 0.01),
        "lru_wa": nrm(ks[10], (DEPTH, LRU_HEADS, LRU_HD, LRU_HD), LRU_HD ** -0.5),
        "lru_ba": nrm(ks[11], (DEPTH, LRU_W), 0.01),
        "lru_wx": nrm(ks[12], (DEPTH, LRU_HEADS, LRU_HD, LRU_HD), LRU_HD ** -0.5),
        "lru_bx": nrm(ks[13], (DEPTH, LRU_W), 0.01),
        "lru_lambda": jnp.log(a0) - jnp.log1p(-a0),
        "ssm_lambda_re": -0.5 + nrm(ks[15], (DEPTH, SSM_G, SSM_P), 0.01),
        "ssm_lambda_im": lam_im_base + nrm(ks[16], (DEPTH, SSM_G, SSM_P), 0.01),
        "ssm_b_re": nrm(ks[17], (DEPTH, SSM_G, SSM_P, SSM_H), (2 * SSM_H) ** -0.5),
        "ssm_b_im": nrm(ks[18], (DEPTH, SSM_G, SSM_P, SSM_H), (2 * SSM_H) ** -0.5),
        "ssm_c_re": nrm(ks[19], (DEPTH, SSM_G, SSM_H, SSM_P), SSM_P ** -0.5),
        "ssm_c_im": nrm(ks[20], (DEPTH, SSM_G, SSM_H, SSM_P), SSM_P ** -0.5),
        "ssm_d": nrm(ks[21], (DEPTH, SSM_W), 0.5),
        "ssm_log_dt": jax.random.uniform(ks[22], (DEPTH, SSM_G), f32, math.log(0.001), math.log(0.1)),
        "ssm_w_glu": nrm(ks[23], (DEPTH, SSM_W, SSM_W), SSM_W ** -0.5),
        "ssm_b_glu": nrm(ks[24], (DEPTH, SSM_W), 0.01),
        "norm_lru_out": gain(ks[25], (DEPTH, LRU_W)),
        "norm_ssm_out": gain(ks[26], (DEPTH, SSM_W)),
        "w_out": nrm(ks[27], (DEPTH, MIX_W, D_MODEL), MIX_W ** -0.5),
        "norm_ffn": gain(ks[28], (DEPTH, D_MODEL)),
        "w_gate": nrm(ks[29], (DEPTH, D_MODEL, D_FF), D_MODEL ** -0.5),
        "w_up": nrm(ks[30], (DEPTH, D_MODEL, D_FF), D_MODEL ** -0.5),
        "w_down": nrm(ks[31], (DEPTH, D_FF, D_MODEL), D_FF ** -0.5),
        "norm_final": gain(ks[32], (D_MODEL,)),
    }


def reference(x_prompt, x_sample, state_conv, state_lru, state_ssm_re, state_ssm_im,
              norm_mix, w_in, conv_w, conv_b, lru_wa, lru_ba, lru_wx, lru_bx, lru_lambda,
              ssm_lambda_re, ssm_lambda_im, ssm_b_re, ssm_b_im, ssm_c_re, ssm_c_im, ssm_d, ssm_log_dt,
              ssm_w_glu, ssm_b_glu, norm_lru_out, norm_ssm_out, w_out, norm_ffn, w_gate, w_up, w_down,
              norm_final):
    bp = x_prompt.shape[0]
    conv0 = jnp.zeros((bp, CONV_W - 1, LRU_W), x_prompt.dtype)
    lru0 = jnp.zeros((bp, LRU_W), jnp.float32)
    re0 = jnp.zeros((bp, SSM_G, SSM_P), jnp.float32)
    im0 = jnp.zeros((bp, SSM_G, SSM_P), jnp.float32)
    yp, ys = x_prompt, x_sample
    pc, pl, pr, pi_, sc, sl, sr, si = [], [], [], [], [], [], [], []
    for l in range(DEPTH):
        p = {
            'norm_mix': norm_mix[l], 'w_in': w_in[l], 'conv_w': conv_w[l], 'conv_b': conv_b[l],
            'lru_wa': lru_wa[l], 'lru_ba': lru_ba[l], 'lru_wx': lru_wx[l], 'lru_bx': lru_bx[l],
            'lru_lambda': lru_lambda[l], 'ssm_lambda_re': ssm_lambda_re[l], 'ssm_lambda_im': ssm_lambda_im[l],
            'ssm_b_re': ssm_b_re[l], 'ssm_b_im': ssm_b_im[l], 'ssm_c_re': ssm_c_re[l], 'ssm_c_im': ssm_c_im[l],
            'ssm_d': ssm_d[l], 'ssm_log_dt': ssm_log_dt[l], 'ssm_w_glu': ssm_w_glu[l], 'ssm_b_glu': ssm_b_glu[l],
            'norm_lru_out': norm_lru_out[l], 'norm_ssm_out': norm_ssm_out[l], 'w_out': w_out[l],
            'norm_ffn': norm_ffn[l], 'w_gate': w_gate[l], 'w_up': w_up[l], 'w_down': w_down[l],
        }
        yp, c1, h1, r1, i1 = _layer(yp, conv0, lru0, re0, im0, p)
        ys, c2, h2, r2, i2 = _layer(ys, state_conv[l], state_lru[l], state_ssm_re[l], state_ssm_im[l], p)
        pc.append(c1); pl.append(h1); pr.append(r1); pi_.append(i1)
        sc.append(c2.astype(state_conv.dtype)); sl.append(h2.astype(state_lru.dtype))
        sr.append(r2.astype(state_ssm_re.dtype)); si.append(i2.astype(state_ssm_im.dtype))
    y_prompt = _rmsnorm(yp, norm_final)
    y_sample = _rmsnorm(ys, norm_final)
    return (y_prompt, y_sample,
            jnp.stack(pc), jnp.stack(pl), jnp.stack(pr), jnp.stack(pi_),
            jnp.stack(sc), jnp.stack(sl), jnp.stack(sr), jnp.stack(si))
```

```cpp
#include <hip/hip_runtime.h>
#include <hip/hip_cooperative_groups.h>
#include <cstdio>
namespace cg = cooperative_groups;

namespace pg8 {
#define PG8_LAS __attribute__((address_space(3)))
typedef unsigned short bf16_t;
typedef short bf16x8 __attribute__((ext_vector_type(8)));
typedef float f32x4 __attribute__((ext_vector_type(4)));
typedef unsigned u32x4 __attribute__((ext_vector_type(4)));
constexpr int BM = 256, BK = 64, HALF = 128, HTB = HALF * BK * 2  , STAGE_BYTES = 8 * HTB, NXCD = 8, WGM = 8;

__host__ __device__ __forceinline__ int lds_byte(int r, int c) { const int st = (r >> 4) * 2 + (c >> 5), rr = r & 15, cc = c & 31, ob = rr * 64 + cc * 2; return st * 1024 + (ob ^ (((ob >> 9) & 1) << 5)); }
__host__ __device__ __forceinline__ void stage_rc(int b, int& R, int& C) { const int st = b / 1024, sb = b % 1024, swz = sb ^ (((sb >> 9) & 1) << 5); R = (st >> 1) * 16 + swz / 64; C = (st & 1) * 32 + (swz % 64) / 2; }
__host__ __device__ __forceinline__ int perm32(int rho) { const int n = rho >> 4, i = rho & 15; return 8 * (i >> 2) + 4 * n + (i & 3); }

struct Unit { int pm, pn; };
struct Gemm { const bf16_t* A; const bf16_t* Bt; int M, N, K; };

struct StaticOrder {
    int nM, nN, nwg, G, c;
    __host__ __device__ void init(int M, int N, int G_, int c_) { nM = M / BM; nN = N / BM; nwg = nM * nN; G = G_; c = c_; }
    __host__ __device__ bool next(int i, Unit& u) const {
        const long L = (long)i * G + c; if (L >= nwg) return false;
        int wgid = (int)L; { const int q = nwg / NXCD, r = nwg % NXCD, xcd = wgid % NXCD, off = wgid / NXCD; wgid = (xcd < r ? xcd * (q + 1) : r * (q + 1) + (xcd - r) * q) + off; }
        const int nig = WGM * nN, gid = wgid / nig, fm = gid * WGM, gsz = (nM - fm) < WGM ? (nM - fm) : WGM;
        u.pm = fm + ((wgid % nig) % gsz); u.pn = (wgid % nig) / gsz; return true;
    }
    __device__ __forceinline__ void a_ready(const Unit&) const {}
    __device__ __forceinline__ void done(const Unit&) const {}
};
__device__ __forceinline__ unsigned cvt_pk_bf16(float lo, float hi) { unsigned r; asm volatile("v_cvt_pk_bf16_f32 %0, %1, %2" : "=v"(r) : "v"(lo), "v"(hi)); return r; }
template <class Epi, class Sched, bool STAMP = false>
__device__ __forceinline__ void gemm_phase(PG8_LAS unsigned char* lds, const Gemm g, const Sched& S, const Epi& E, unsigned long long* stamps) {
    int tid_ = threadIdx.x; asm volatile("" : "+v"(tid_));
    const int tid = tid_, wid = __builtin_amdgcn_readfirstlane(tid >> 6), lane = tid & 63, wr = wid >> 2, wc = wid & 3, fr = lane & 15, fq = lane >> 4;
    const int K = g.K, nt = K / BK;
    int ts_lo = 0, ts_hi = 0, nts = 0; const unsigned long long rt_entry = STAMP ? (unsigned long long)wall_clock64() : 0ull;
#define PG8_STAMP() do { if (STAMP && wid == 0 && nts < 64) { const unsigned long long _c = (unsigned long long)clock64(); \
        ts_lo = (lane == nts) ? (int)(unsigned)_c : ts_lo; ts_hi = (lane == nts) ? (int)(unsigned)(_c >> 32) : ts_hi; ++nts; } } while (0)
    PG8_STAMP();
    unsigned voffA[2], voffB[2];
#pragma unroll
    for (int i = 0; i < 2; ++i) { int R, C; stage_rc(tid * 16 + i * 8192, R, C); const int Rb = Epi::PERM ? ((R & ~31) + perm32(R & 31)) : R;
        voffA[i] = (unsigned)(R * K + C) * 2u; voffB[i] = (unsigned)(Rb * K + C) * 2u; }
    const size_t kstep = (size_t)(BK * 2);
    const size_t hstep = (size_t)HALF * K * 2;
    const size_t tstep = 2 * hstep;
    const unsigned ldsw = (unsigned)wid * 1024u;
    const int aoff = lds_byte(wr * 64 + fr, fq * 8), boff = lds_byte(wc * 32 + fr, fq * 8);
#define PG8_SA(b, h) (((b) * 2 + (h)) * HTB)
#define PG8_SB(b, h) ((4 + (b) * 2 + (h)) * HTB)
#define PG8_STAGE(bufoff, gbase, voff) do { _Pragma("unroll") for (int _i = 0; _i < 2; ++_i) \
        __builtin_amdgcn_global_load_lds((const unsigned*)((const char*)(gbase) + (voff)[_i]), (PG8_LAS unsigned*)(lds + (bufoff) + ldsw + _i * 8192), 16, 0, 0); } while (0)
#define PG8_LDA(dst, b, h) do { _Pragma("unroll") for (int m = 0; m < 4; ++m) _Pragma("unroll") for (int k = 0; k < 2; ++k) dst[m][k] = *(const PG8_LAS bf16x8*)(lds + PG8_SA(b, h) + aoff + m * 2048 + k * 1024); } while (0)
#define PG8_LDB(dst, b, h) do { _Pragma("unroll") for (int n = 0; n < 2; ++n) _Pragma("unroll") for (int k = 0; k < 2; ++k) dst[n][k] = *(const PG8_LAS bf16x8*)(lds + PG8_SB(b, h) + boff + n * 2048 + k * 1024); } while (0)
#define PG8_MMA(ai, bj, At, Bt) do { __builtin_amdgcn_s_setprio(1); _Pragma("unroll") for (int m = 0; m < 4; ++m) _Pragma("unroll") for (int n = 0; n < 2; ++n) _Pragma("unroll") for (int k = 0; k < 2; ++k) \
        acc[ai][bj][m][n] = __builtin_amdgcn_mfma_f32_16x16x32_bf16(Bt[n][k], At[m][k], acc[ai][bj][m][n], 0, 0, 0); __builtin_amdgcn_s_setprio(0); } while (0)
#define PG8_WAIT_V(n) asm volatile("s_waitcnt vmcnt(" #n ")" ::: "memory")
#define PG8_WAIT_L(n) asm volatile("s_waitcnt lgkmcnt(" #n ")" ::: "memory")
#define PG8_BAR __builtin_amdgcn_s_barrier()
#define PG8_SCHED __builtin_amdgcn_sched_barrier(0)
    Unit cur, nxt; int ui = 0;
    if (!S.next(0, cur)) return;
    f32x4 acc[2][2][4][2];
#pragma unroll
    for (int a = 0; a < 2; ++a)
#pragma unroll
        for (int b = 0; b < 2; ++b)
#pragma unroll
            for (int m = 0; m < 4; ++m)
#pragma unroll
                for (int n = 0; n < 2; ++n) acc[a][b][m][n] = (f32x4){0.f, 0.f, 0.f, 0.f};
    bf16x8 At[4][2], B0[2][2], B1[2][2];
    const char* cA = (const char*)g.A + (size_t)cur.pm * tstep; const char* cB = (const char*)g.Bt + (size_t)cur.pn * tstep;
    S.a_ready(cur);
    PG8_STAGE(PG8_SB(0, 0), cB, voffB); PG8_STAGE(PG8_SA(0, 0), cA, voffA); PG8_STAGE(PG8_SB(0, 1), cB + hstep, voffB); PG8_STAGE(PG8_SA(0, 1), cA + hstep, voffA);
    if (wr == 1) PG8_BAR;
    PG8_WAIT_V(4); PG8_BAR;
    PG8_STAGE(PG8_SB(1, 0), cB + kstep, voffB); PG8_STAGE(PG8_SA(1, 0), cA + kstep, voffA); PG8_STAGE(PG8_SB(1, 1), cB + hstep + kstep, voffB);
    PG8_WAIT_V(6); PG8_BAR;
    PG8_STAMP();
    for (;;) {
        const bool has_next = S.next(ui + 1, nxt);
        const char* nA = has_next ? (const char*)g.A + (size_t)nxt.pm * tstep : cA; const char* nB = has_next ? (const char*)g.Bt + (size_t)nxt.pn * tstep : cB;
        for (int t = 0; t < nt; t += 2) {
            const bool last = (t == nt - 2);
            const char* a1 = cA + (size_t)(t + 1) * kstep;
            const char* a2 = last ? nA : cA + (size_t)(t + 2) * kstep; const char* b2 = last ? nB : cB + (size_t)(t + 2) * kstep;
            const char* a3 = a2 + kstep; const char* b3 = b2 + kstep;
            if (last && has_next) S.a_ready(nxt);
            PG8_LDB(B0, 0, 0); PG8_SCHED; PG8_LDA(At, 0, 0); PG8_STAGE(PG8_SA(1, 1), a1 + hstep, voffA);
            PG8_WAIT_L(8); PG8_BAR; PG8_WAIT_L(0); PG8_MMA(0, 0, At, B0); PG8_BAR; PG8_SCHED;
            PG8_LDB(B1, 0, 1); PG8_STAGE(PG8_SB(0, 0), b2, voffB);
            PG8_BAR; PG8_WAIT_L(0); PG8_MMA(0, 1, At, B1); PG8_BAR;
            PG8_LDA(At, 0, 1); PG8_STAGE(PG8_SA(0, 0), a2, voffA);
            PG8_BAR; PG8_WAIT_L(0); PG8_MMA(1, 0, At, B0); PG8_BAR; PG8_SCHED;
            PG8_STAGE(PG8_SB(0, 1), b2 + hstep, voffB);
            PG8_WAIT_V(6); PG8_BAR; PG8_MMA(1, 1, At, B1); PG8_BAR;
            PG8_LDB(B0, 1, 0); PG8_SCHED; PG8_LDA(At, 1, 0); PG8_STAGE(PG8_SA(0, 1), a2 + hstep, voffA);
            PG8_WAIT_L(8); PG8_BAR; PG8_WAIT_L(0); PG8_MMA(0, 0, At, B0); PG8_BAR; PG8_SCHED;
            PG8_LDB(B1, 1, 1); PG8_STAGE(PG8_SB(1, 0), b3, voffB);
            PG8_BAR; PG8_WAIT_L(0); PG8_MMA(0, 1, At, B1); PG8_BAR;
            PG8_LDA(At, 1, 1); PG8_STAGE(PG8_SA(1, 0), a3, voffA);
            PG8_BAR; PG8_WAIT_L(0); PG8_MMA(1, 0, At, B0); PG8_BAR; PG8_SCHED;
            PG8_STAGE(PG8_SB(1, 1), b3 + hstep, voffB);
            PG8_WAIT_V(6); PG8_BAR; PG8_MMA(1, 1, At, B1); PG8_BAR;
        }
        PG8_STAMP();
        if constexpr (!Epi::AFTER_DRAIN) { E(acc, cur, wr, wc, fr, fq); S.done(cur); }
        PG8_STAMP();
        if (!has_next) break;
#pragma unroll
        for (int a = 0; a < 2; ++a)
#pragma unroll
            for (int b = 0; b < 2; ++b)
#pragma unroll
                for (int m = 0; m < 4; ++m)
#pragma unroll
                    for (int n = 0; n < 2; ++n) acc[a][b][m][n] = (f32x4){0.f, 0.f, 0.f, 0.f};
        cur = nxt; cA = nA; cB = nB; ++ui;
    }
    PG8_WAIT_V(0);
    if (wr == 0) PG8_BAR;
    PG8_BAR;
    if constexpr (Epi::AFTER_DRAIN) { E.fused(acc, cur, wr, wc, fr, fq, lds, wid, lane); S.done(cur); }
    PG8_STAMP();
    if (STAMP && wid == 0) { stamps[lane] = lane < nts ? (((unsigned long long)(unsigned)ts_hi << 32) | (unsigned)ts_lo) : 0ull;
        if (lane == 62) stamps[62] = rt_entry; if (lane == 63) stamps[63] = (unsigned long long)wall_clock64(); }
#undef PG8_STAMP
#undef PG8_SA
#undef PG8_SB
#undef PG8_STAGE
#undef PG8_LDA
#undef PG8_LDB
#undef PG8_MMA
#undef PG8_WAIT_V
#undef PG8_WAIT_L
#undef PG8_BAR
#undef PG8_SCHED
}
}

using pg8::bf16_t; using pg8::bf16x8; using pg8::f32x4; using pg8::Unit; using pg8::cvt_pk_bf16;
typedef short bf16x4 __attribute__((ext_vector_type(4)));
typedef unsigned u32x4 __attribute__((ext_vector_type(4)));
typedef unsigned u32x2 __attribute__((ext_vector_type(2)));

constexpr int TP = 16384, TT = 16640, DM = 1024, INW = 1536, DFF = 2816, NGU = 5632;
constexpr int NPT = 512;
constexpr float EPS = 1e-6f;

constexpr size_t SZ_WIN = (size_t)1536 * 1024 * 2, SZ_WOUT = (size_t)1024 * 1024 * 2, SZ_WGU = (size_t)5632 * 1024 * 2, SZ_WDN = (size_t)1024 * 2816 * 2,
                 SZ_WGLU = (size_t)512 * 512 * 2, SZ_WAX = (size_t)2 * 8 * 64 * 64 * 2;
constexpr size_t OFF_WIN = 0;
constexpr size_t OFF_WOUT = OFF_WIN + 2 * SZ_WIN;
constexpr size_t OFF_WGU = OFF_WOUT + 2 * SZ_WOUT;
constexpr size_t OFF_WDN = OFF_WGU + 2 * SZ_WGU;
constexpr size_t OFF_WGLU = OFF_WDN + 2 * SZ_WDN;
constexpr size_t OFF_WAX = OFF_WGLU + 2 * SZ_WGLU;
constexpr size_t OFF_BB = OFF_WAX + 2 * SZ_WAX;
constexpr size_t OFF_CM = OFF_BB + (size_t)2 * 32 * 128 * 16 * 2;
constexpr size_t OFF_LB = OFF_CM + (size_t)2 * 32 * 16 * 128 * 2;
constexpr size_t OFF_SS = OFF_LB + (size_t)2 * 4 * 2048 * 4;
constexpr size_t OFF_LRUA = OFF_SS + (size_t)5 * TT * 4;
constexpr size_t OFF_LRUB = OFF_LRUA + (size_t)NPT * 512 * 4;
constexpr size_t OFF_LRUC = OFF_LRUB + (size_t)NPT * 512 * 4;
constexpr size_t OFF_S5E = OFF_LRUC + (size_t)NPT * 512 * 4;
constexpr size_t OFF_S5C = OFF_S5E + (size_t)NPT * 2 * 2048 * 4;
constexpr size_t OFF_XB = OFF_S5C + (size_t)NPT * 2 * 2048 * 4;
constexpr size_t OFF_R = OFF_XB + (size_t)TT * 1024 * 2;
constexpr size_t OFF_Z = OFF_R, OFF_MIX = OFF_R + (size_t)TT * 1536 * 2, OFF_FF = OFF_R;
constexpr size_t WS_END = OFF_R + (size_t)TT * 2816 * 2;

constexpr size_t O_Y = 0, O_CONV_P = (size_t)TT * 1024, O_LRU_P = O_CONV_P + 3072, O_RE_P = O_LRU_P + 1024, O_IM_P = O_RE_P + 4096,
                 O_CONV_S = O_IM_P + 4096, O_LRU_S = O_CONV_S + 24576, O_RE_S = O_LRU_S + 8192, O_IM_S = O_RE_S + 32768;

constexpr int LDS_GT = 32 * 520 * 2;
constexpr int LDS_WSC = 8704 + 4352;
constexpr int LDS_BYTES = 139264;

struct Params { const float* in[33]; float* out; unsigned char* ws; };

__device__ __forceinline__ bf16_t f2bf(float f) { unsigned u = __float_as_uint(f); u += 0x7FFFu + ((u >> 16) & 1u); return (bf16_t)(u >> 16); }
__device__ __forceinline__ float bf2f(bf16_t b) { return __uint_as_float(((unsigned)b) << 16); }
__device__ __forceinline__ float sigm(float x) { return __builtin_amdgcn_rcpf(1.f + __expf(-x)); }
__device__ __forceinline__ float gelu_t(float x) { return x * sigm(1.5957691216057308f * (x + 0.044715f * x * x * x)); }
__device__ __forceinline__ int opaque_tid() { int t = threadIdx.x; asm volatile("" : "+v"(t)); return t; }
#define WAVE_SYNC() do { __builtin_amdgcn_fence(__ATOMIC_RELEASE, "wavefront"); __builtin_amdgcn_wave_barrier(); __builtin_amdgcn_fence(__ATOMIC_ACQUIRE, "wavefront"); } while (0)

struct EpiZ {
    static constexpr bool PERM = true, AFTER_DRAIN = false;
    bf16_t* O; const float* ss;
    __device__ __forceinline__ void operator()(const f32x4 (&acc)[2][2][4][2], const Unit& u, int wr, int wc, int fr, int fq) const {
        const int row0 = u.pm * 256 + wr * 64 + fr, col0 = u.pn * 256 + wc * 32 + 8 * fq;
#pragma unroll
        for (int ai = 0; ai < 2; ++ai)
#pragma unroll
            for (int m = 0; m < 4; ++m) {
                const int row = row0 + ai * 128 + m * 16; const float rs = rsqrtf(ss[row] * (1.f / 1024.f) + EPS);
                bf16_t* rp = O + (size_t)row * INW + col0;
#pragma unroll
                for (int bj = 0; bj < 2; ++bj) { const f32x4 v0 = acc[ai][bj][m][0] * rs, v1 = acc[ai][bj][m][1] * rs;
                    u32x4 pk; pk[0] = cvt_pk_bf16(v0[0], v0[1]); pk[1] = cvt_pk_bf16(v0[2], v0[3]); pk[2] = cvt_pk_bf16(v1[0], v1[1]); pk[3] = cvt_pk_bf16(v1[2], v1[3]);
                    *(u32x4*)(rp + bj * 128) = pk; }
            }
    }
};
struct EpiFF {
    static constexpr bool PERM = true, AFTER_DRAIN = false;
    bf16_t* O; const float* ss;
    __device__ __forceinline__ void operator()(const f32x4 (&acc)[2][2][4][2], const Unit& u, int wr, int wc, int fr, int fq) const {
        const int row0 = u.pm * 256 + wr * 64 + fr, f0 = u.pn * 128 + wc * 32 + 8 * fq;
#pragma unroll
        for (int ai = 0; ai < 2; ++ai)
#pragma unroll
            for (int m = 0; m < 4; ++m) {
                const int row = row0 + ai * 128 + m * 16; const float rs = rsqrtf(ss[row] * (1.f / 1024.f) + EPS);
                float o[8];
#pragma unroll
                for (int n = 0; n < 2; ++n)
#pragma unroll
                    for (int i = 0; i < 4; ++i) { const float g = acc[ai][0][m][n][i] * rs, up = acc[ai][1][m][n][i] * rs; o[n * 4 + i] = g * sigm(g) * up; }
                u32x4 pk; pk[0] = cvt_pk_bf16(o[0], o[1]); pk[1] = cvt_pk_bf16(o[2], o[3]); pk[2] = cvt_pk_bf16(o[4], o[5]); pk[3] = cvt_pk_bf16(o[6], o[7]);
                *(u32x4*)(O + (size_t)row * DFF + f0) = pk;
            }
    }
};
struct EpiRes {
    static constexpr bool PERM = false, AFTER_DRAIN = false;
    const float* xa; const float* xs; float* xo; bf16_t* xbo; float* ss;
    __device__ __forceinline__ void operator()(const f32x4 (&acc)[2][2][4][2], const Unit& u, int wr, int wc, int fr, int fq) const {
        const int row0 = u.pm * 256 + wr * 64 + fr, col0 = u.pn * 256 + wc * 32 + 4 * fq;
#pragma unroll
        for (int ai = 0; ai < 2; ++ai)
#pragma unroll
            for (int m = 0; m < 4; ++m) {
                const int row = row0 + ai * 128 + m * 16;
                const float* ip = (row < TP ? xa + (size_t)row * 1024 : xs + (size_t)(row - TP) * 1024) + col0;
                float* op = xo + (size_t)row * 1024 + col0; bf16_t* bp = xbo + (size_t)row * 1024 + col0; float s = 0.f;
#pragma unroll
                for (int bj = 0; bj < 2; ++bj)
#pragma unroll
                    for (int n = 0; n < 2; ++n) { const f32x4 v = *(const f32x4*)(ip + bj * 128 + n * 16) + acc[ai][bj][m][n];
                        *(f32x4*)(op + bj * 128 + n * 16) = v; u32x2 pk; pk[0] = cvt_pk_bf16(v[0], v[1]); pk[1] = cvt_pk_bf16(v[2], v[3]); *(u32x2*)(bp + bj * 128 + n * 16) = pk;
                        s += v[0] * v[0] + v[1] * v[1] + v[2] * v[2] + v[3] * v[3]; }
                s += __shfl_xor(s, 16); s += __shfl_xor(s, 32);
                if (fq == 0) atomicAdd(ss + row, s);
            }
    }
};
template <class Epi> __device__ __forceinline__ void run_gemm(unsigned char* lds, const bf16_t* A, const bf16_t* Bt, int M, int N, int K, const Epi& E) {
    pg8::Gemm g{A, Bt, M, N, K}; pg8::StaticOrder S; S.init(M, N, (int)gridDim.x, (int)blockIdx.x);
    pg8::gemm_phase<Epi, pg8::StaticOrder, false>((PG8_LAS unsigned char*)lds, g, S, E, nullptr);
}

__device__ __forceinline__ void tr_tile(const float* src, int N, int k0, int n0, const float* gain, bf16_t* dst, int K, int dstrow0, float* tile, const int tid) {
    __syncthreads();
#pragma unroll
    for (int i = 0; i < 2; ++i) { const int kk = (tid >> 4) + i * 32, nq = tid & 15; const float4 v = *(const float4*)(src + (size_t)(k0 + kk) * N + n0 + nq * 4);
        const float g = gain ? gain[kk] : 1.f; float* t = tile + kk * 65 + nq * 4; t[0] = v.x * g; t[1] = v.y * g; t[2] = v.z * g; t[3] = v.w * g; }
    __syncthreads();
    const int n = tid >> 3, kq = tid & 7; const float* t = tile + (kq * 8) * 65 + n;
    u32x4 pk; pk[0] = cvt_pk_bf16(t[0], t[65]); pk[1] = cvt_pk_bf16(t[130], t[195]); pk[2] = cvt_pk_bf16(t[260], t[325]); pk[3] = cvt_pk_bf16(t[390], t[455]);
    *(u32x4*)(dst + (size_t)(dstrow0 + n) * K + k0 + kq * 8) = pk;
}

__device__ __forceinline__ void prep_phase(const Params& P, unsigned char* lds) {
    float* tile = (float*)lds; unsigned char* ws = P.ws;
    const int tid = opaque_tid(), wid = tid >> 6, lane = tid & 63;
    const int gtid = blockIdx.x * 512 + tid, gsz = gridDim.x * 512;
    for (int row = blockIdx.x * 8 + wid; row < TT; row += gridDim.x * 8) {
        const float* xr = row < TP ? P.in[0] + (size_t)row * 1024 : P.in[1] + (size_t)(row - TP) * 1024; bf16_t* xb = (bf16_t*)(ws + OFF_XB) + (size_t)row * 1024; float s = 0.f;
#pragma unroll
        for (int j = 0; j < 4; ++j) { const float4 v = *(const float4*)(xr + j * 256 + lane * 4); s += v.x * v.x + v.y * v.y + v.z * v.z + v.w * v.w;
            u32x2 pk; pk[0] = cvt_pk_bf16(v.x, v.y); pk[1] = cvt_pk_bf16(v.z, v.w); *(u32x2*)(xb + j * 256 + lane * 4) = pk; }
#pragma unroll
        for (int o = 1; o < 64; o <<= 1) s += __shfl_xor(s, o);
        if (lane == 0) ((float*)(ws + OFF_SS))[row] = s;
    }
    for (int i = gtid; i < 4 * TT; i += gsz) ((float*)(ws + OFF_SS))[TT + i] = 0.f;
    for (int i = gtid; i < 2 * 2 * 8 * 4096; i += gsz) { const int e = i & 4095, hh = (i >> 12) & 7, which = (i >> 15) & 1, l = i >> 16, j = e >> 6, ii = e & 63;
        const float* w = which ? P.in[12] : P.in[10]; ((bf16_t*)(ws + OFF_WAX))[i] = f2bf(w[((size_t)(l * 8 + hh) * 64 + ii) * 64 + j]); }
    for (int i = gtid; i < 4096; i += gsz) { const int l = i >> 11, gp = i & 2047, g = gp >> 6, p = gp & 63;
        const float lr = P.in[15][i], li = P.in[16][i], dt = expf(P.in[22][l * 32 + g]);
        const float mag = expf(lr * dt), lbr = mag * cosf(li * dt), lbi = mag * sinf(li * dt);
        const float nr = lbr - 1.f, ni = lbi, den = lr * lr + li * li, gr = (nr * lr + ni * li) / den, gi = (ni * lr - nr * li) / den;
        const float* br = P.in[17] + (size_t)i * 16; const float* bi = P.in[18] + (size_t)i * 16;
        bf16_t* bb = (bf16_t*)(ws + OFF_BB) + ((size_t)(l * 32 + g) * 128) * 16;
        for (int h = 0; h < 16; ++h) { bb[(size_t)p * 16 + h] = f2bf(gr * br[h] - gi * bi[h]); bb[(size_t)(64 + p) * 16 + h] = f2bf(gr * bi[h] + gi * br[h]); }
        bf16_t* cm = (bf16_t*)(ws + OFF_CM) + ((size_t)(l * 32 + g) * 16) * 128;
        for (int h = 0; h < 16; ++h) { cm[h * 128 + p] = f2bf(P.in[19][((size_t)(l * 32 + g) * 16 + h) * 64 + p]); cm[h * 128 + 64 + p] = f2bf(-P.in[20][((size_t)(l * 32 + g) * 16 + h) * 64 + p]); }
        float pr = lbr, pi = lbi;
        for (int s = 0; s < 5; ++s) { const float t = pr * pr - pi * pi; pi = 2.f * pr * pi; pr = t; }
        float* lb = (float*)(ws + OFF_LB) + (size_t)l * 4 * 2048; lb[gp] = lbr; lb[2048 + gp] = lbi; lb[4096 + gp] = pr; lb[6144 + gp] = pi; }
    for (int it = blockIdx.x; it < 5632; it += gridDim.x) {
        const int l = it / 2816; int i = it % 2816; const float* src; int N, K, kt, nt, drow; const float* gain; bf16_t* dst;
        if (i < 384) { kt = i / 24; nt = i % 24; src = P.in[7] + (size_t)l * 1024 * 1536; N = 1536; K = 1024; gain = P.in[6] + l * 1024 + kt * 64; dst = (bf16_t*)(ws + OFF_WIN + l * SZ_WIN); drow = nt * 64; }
        else if (i < 640) { i -= 384; kt = i / 16; nt = i % 16; src = P.in[27] + (size_t)l * 1024 * 1024; N = 1024; K = 1024;
            gain = kt < 8 ? P.in[25] + l * 512 + kt * 64 : P.in[26] + l * 512 + (kt - 8) * 64; dst = (bf16_t*)(ws + OFF_WOUT + l * SZ_WOUT); drow = nt * 64; }
        else if (i < 2048) { const bool up = i >= 1344; i -= up ? 1344 : 640; kt = i / 44; nt = i % 44; src = (up ? P.in[30] : P.in[29]) + (size_t)l * 1024 * 2816; N = 2816; K = 1024;
            gain = P.in[28] + l * 1024 + kt * 64; dst = (bf16_t*)(ws + OFF_WGU + l * SZ_WGU); const int f0 = nt * 64; drow = (f0 >> 7) * 256 + (f0 & 127) + (up ? 128 : 0); }
        else if (i < 2752) { i -= 2048; kt = i / 16; nt = i % 16; src = P.in[31] + (size_t)l * 2816 * 1024; N = 1024; K = 2816; gain = nullptr; dst = (bf16_t*)(ws + OFF_WDN + l * SZ_WDN); drow = nt * 64; }
        else { i -= 2752; kt = i / 8; nt = i % 8; src = P.in[23] + (size_t)l * 512 * 512; N = 512; K = 512; gain = nullptr; dst = (bf16_t*)(ws + OFF_WGLU + l * SZ_WGLU); drow = nt * 64; }
        tr_tile(src, N, kt * 64, nt * 64, gain, dst, K, drow, tile, tid);
    }
    __syncthreads();
}

__device__ __forceinline__ void norm_store(const bf16_t* gtile, bf16_t* dst) {
    const int tid = opaque_tid(), tok = tid >> 4, part = tid & 15; const bf16_t* src = gtile + tok * 520 + part * 32;
    float v[32]; float s = 0.f;
#pragma unroll
    for (int q = 0; q < 4; ++q) { const u32x4 w = *(const u32x4*)(src + q * 8);
#pragma unroll
        for (int e = 0; e < 4; ++e) { const float a = __uint_as_float(w[e] << 16), b = __uint_as_float(w[e] & 0xFFFF0000u); v[q * 8 + e * 2] = a; v[q * 8 + e * 2 + 1] = b; s += a * a + b * b; } }
    s += __shfl_xor(s, 1); s += __shfl_xor(s, 2); s += __shfl_xor(s, 4); s += __shfl_xor(s, 8);
    const float rs = rsqrtf(s * (1.f / 512.f) + EPS);
    bf16_t* d = dst + (size_t)tok * 1024 + part * 32;
#pragma unroll
    for (int q = 0; q < 4; ++q) { u32x4 pk;
#pragma unroll
        for (int e = 0; e < 4; ++e) pk[e] = cvt_pk_bf16(v[q * 8 + e * 2] * rs, v[q * 8 + e * 2 + 1] * rs);
        *(u32x4*)(d + q * 8) = pk; }
}

template <bool FINAL>
__device__ __forceinline__ void mixer_tile(const Params& P, int l, int tile, unsigned char* lds) {
    const int tid = opaque_tid(), wid = tid >> 6, lane = tid & 63, fr = lane & 15, fq = lane >> 4;
    unsigned char* ws = P.ws;
    const bool samp = tile >= NPT; const int sb = tile - NPT;
    const int row0 = samp ? TP + sb * 32 : tile * 32;
    const bool seq_start = samp || tile == 0, seq_end = samp || tile == NPT - 1;
    bf16_t* gtile = (bf16_t*)lds;
    unsigned char* wsc = lds + LDS_GT + wid * LDS_WSC;
    float* regA = (float*)wsc; bf16_t* regB = (bf16_t*)(wsc + 8704);
    const bf16_t* Z = (const bf16_t*)(ws + OFF_Z);
    bf16_t* MIX = (bf16_t*)(ws + OFF_MIX);
    __syncthreads();
    {
        const int c = wid * 64 + lane;
        const float* cw = P.in[8] + (size_t)l * 4 * 512; const float cw0 = cw[c], cw1 = cw[512 + c], cw2 = cw[1024 + c], cw3 = cw[1536 + c];
        const float cb = P.in[9][l * 512 + c], ba = P.in[11][l * 512 + c], bx = P.in[13][l * 512 + c];
        const float sp8 = -8.f * log1pf(expf(-P.in[14][l * 512 + c]));
        float x3, x2, x1;
        if (seq_start) { if (samp) { const float* sc = P.in[2] + ((size_t)(l * 8 + sb) * 3) * 512; x3 = sc[c]; x2 = sc[512 + c]; x1 = sc[1024 + c]; } else { x3 = 0.f; x2 = 0.f; x1 = 0.f; } }
        else { const bf16_t* zp = Z + (size_t)(row0 - 3) * INW + c; x3 = bf2f(zp[0]); x2 = bf2f(zp[INW]); x1 = bf2f(zp[2 * INW]); }
        float h = 0.f, Pa = 1.f;
        if (FINAL) h = samp ? P.in[3][(size_t)(l * 8 + sb) * 512 + c] : ((const float*)(ws + OFF_LRUC))[(size_t)tile * 512 + c];
        const bf16_t* wa = (const bf16_t*)(ws + OFF_WAX) + ((size_t)(l * 2 + 0) * 8 + wid) * 4096;
        const bf16_t* wx = (const bf16_t*)(ws + OFF_WAX) + ((size_t)(l * 2 + 1) * 8 + wid) * 4096;
        bf16x8 waf[4][2], wxf[4][2];
#pragma unroll
        for (int jt = 0; jt < 4; ++jt)
#pragma unroll
            for (int kk = 0; kk < 2; ++kk) { waf[jt][kk] = *(const bf16x8*)(wa + (jt * 16 + fr) * 64 + kk * 32 + fq * 8); wxf[jt][kk] = *(const bf16x8*)(wx + (jt * 16 + fr) * 64 + kk * 32 + fq * 8); }
        bf16_t* xcs = regB; bf16_t* gls = regB + 16 * 72; float* pre = regA;
#pragma unroll 1
        for (int sub = 0; sub < 2; ++sub) {
            const bf16_t* zr = Z + (size_t)(row0 + sub * 16) * INW + c;
#pragma unroll
            for (int tt = 0; tt < 16; ++tt) { const float x0 = bf2f(zr[(size_t)tt * INW]); const float xc = cb + cw0 * x3 + cw1 * x2 + cw2 * x1 + cw3 * x0; x3 = x2; x2 = x1; x1 = x0; xcs[tt * 72 + lane] = f2bf(xc);
                if (FINAL) gls[tt * 64 + lane] = zr[(size_t)tt * INW + 512]; }
            WAVE_SYNC();
            f32x4 aa[4], ax[4];
#pragma unroll
            for (int jt = 0; jt < 4; ++jt) { aa[jt] = (f32x4){0.f, 0.f, 0.f, 0.f}; ax[jt] = (f32x4){0.f, 0.f, 0.f, 0.f}; }
#pragma unroll
            for (int kk = 0; kk < 2; ++kk) { const bf16x8 bfv = *(const bf16x8*)(xcs + fr * 72 + kk * 32 + fq * 8);
#pragma unroll
                for (int jt = 0; jt < 4; ++jt) { aa[jt] = __builtin_amdgcn_mfma_f32_16x16x32_bf16(waf[jt][kk], bfv, aa[jt], 0, 0, 0); ax[jt] = __builtin_amdgcn_mfma_f32_16x16x32_bf16(wxf[jt][kk], bfv, ax[jt], 0, 0, 0); } }
#pragma unroll
            for (int jt = 0; jt < 4; ++jt)
#pragma unroll
                for (int r = 0; r < 4; ++r) { pre[(jt * 16 + fq * 4 + r) * 17 + fr] = aa[jt][r]; pre[1088 + (jt * 16 + fq * 4 + r) * 17 + fr] = ax[jt][r]; }
            WAVE_SYNC();
#pragma unroll 4
            for (int tt = 0; tt < 16; ++tt) {
                const float rg = sigm(pre[lane * 17 + tt] + ba), ig = sigm(pre[1088 + lane * 17 + tt] + bx), xc = bf2f(xcs[tt * 72 + lane]);
                const float la = sp8 * rg, a = __expf(la), b = __builtin_amdgcn_sqrtf(fmaxf(-expm1f(2.f * la), 0.f)) * (ig * xc);
                h = a * h + b; Pa *= a;
                if (FINAL) { const float gl = bf2f(gls[tt * 64 + lane]); gtile[(sub * 16 + tt) * 520 + c] = f2bf(h * gelu_t(gl)); }
            }
            WAVE_SYNC();
        }
        if (!FINAL) { ((float*)(ws + OFF_LRUA))[(size_t)tile * 512 + c] = Pa; ((float*)(ws + OFF_LRUB))[(size_t)tile * 512 + c] = h; }
        else if (seq_end) {
            float* oc = P.out + (samp ? O_CONV_S + ((size_t)(l * 8 + sb) * 3) * 512 : O_CONV_P + (size_t)l * 3 * 512);
            oc[c] = x3; oc[512 + c] = x2; oc[1024 + c] = x1;
            P.out[(samp ? O_LRU_S + (size_t)(l * 8 + sb) * 512 : O_LRU_P + (size_t)l * 512) + c] = h;
        }
    }
    if (FINAL) { __syncthreads(); norm_store(gtile, MIX + (size_t)row0 * 1024); __syncthreads(); }
#pragma unroll 1
    for (int gi = 0; gi < 4; ++gi) {
        const int g = wid * 4 + gi, p = lane;
        const float* lb = (const float*)(ws + OFF_LB) + (size_t)l * 4 * 2048;
        const float lbr = lb[g * 64 + p], lbi = lb[2048 + g * 64 + p];
        float xr = 0.f, xi = 0.f;
        if (FINAL) { if (samp) { xr = P.in[4][((size_t)(l * 8 + sb) * 32 + g) * 64 + p]; xi = P.in[5][((size_t)(l * 8 + sb) * 32 + g) * 64 + p]; }
                     else { const float* cc = (const float*)(ws + OFF_S5C) + (size_t)tile * 4096; xr = cc[g * 64 + p]; xi = cc[2048 + g * 64 + p]; } }
        const bf16_t* bb = (const bf16_t*)(ws + OFF_BB) + ((size_t)(l * 32 + g) * 128) * 16;
        bf16x4 bbf[8];
#pragma unroll
        for (int nt = 0; nt < 8; ++nt) bbf[nt] = *(const bf16x4*)(bb + (size_t)(nt * 16 + fr) * 16 + fq * 4);
        bf16x8 cmf[4];
        if (FINAL) { const bf16_t* cm = (const bf16_t*)(ws + OFF_CM) + ((size_t)(l * 32 + g) * 16 + fr) * 128;
#pragma unroll
            for (int kk = 0; kk < 4; ++kk) cmf[kk] = *(const bf16x8*)(cm + kk * 32 + fq * 8); }
        const float dsk = FINAL ? P.in[21][l * 512 + g * 16 + fr] : 0.f;
        float* Bu = regA; bf16_t* xs = regB;
#pragma unroll 1
        for (int sub = 0; sub < 2; ++sub) {
            const bf16_t* zu = Z + (size_t)(row0 + sub * 16) * INW + 1024 + g * 16;
            const bf16x4 uf = *(const bf16x4*)(zu + (size_t)fr * INW + fq * 4);
#pragma unroll
            for (int nt = 0; nt < 8; ++nt) { const f32x4 d = __builtin_amdgcn_mfma_f32_16x16x16bf16_1k(bbf[nt], uf, (f32x4){0.f, 0.f, 0.f, 0.f}, 0, 0, 0);
#pragma unroll
                for (int r = 0; r < 4; ++r) Bu[(nt * 16 + fq * 4 + r) * 17 + fr] = d[r]; }
            WAVE_SYNC();
#pragma unroll
            for (int tt = 0; tt < 16; ++tt) { const float bur = Bu[p * 17 + tt], bui = Bu[(64 + p) * 17 + tt];
                const float nxr = lbr * xr - lbi * xi + bur, nxi = lbr * xi + lbi * xr + bui; xr = nxr; xi = nxi;
                if (FINAL) { xs[tt * 136 + p] = f2bf(xr); xs[tt * 136 + 64 + p] = f2bf(xi); } }
            if (FINAL) {
                WAVE_SYNC();
                f32x4 y = (f32x4){0.f, 0.f, 0.f, 0.f};
#pragma unroll
                for (int kk = 0; kk < 4; ++kk) { const bf16x8 af = *(const bf16x8*)(xs + fr * 136 + kk * 32 + fq * 8); y = __builtin_amdgcn_mfma_f32_16x16x32_bf16(af, cmf[kk], y, 0, 0, 0); }
#pragma unroll
                for (int r = 0; r < 4; ++r) { const int tok = fq * 4 + r; const float u = bf2f(zu[(size_t)tok * INW + fr]); gtile[(sub * 16 + tok) * 520 + g * 16 + fr] = f2bf(gelu_t(y[r] + dsk * u)); }
            }
            WAVE_SYNC();
        }
        if (!FINAL) { float* e = (float*)(ws + OFF_S5E) + (size_t)tile * 4096; e[g * 64 + p] = xr; e[2048 + g * 64 + p] = xi; }
        else if (seq_end) { const size_t o = samp ? ((size_t)(l * 8 + sb) * 32 + g) * 64 + p : ((size_t)l * 32 + g) * 64 + p;
            P.out[(samp ? O_RE_S : O_RE_P) + o] = xr; P.out[(samp ? O_IM_S : O_IM_P) + o] = xi; }
    }
    if (FINAL) {
        __syncthreads();
        f32x4 acc[2][4];
#pragma unroll
        for (int mt = 0; mt < 2; ++mt)
#pragma unroll
            for (int nt = 0; nt < 4; ++nt) acc[mt][nt] = (f32x4){0.f, 0.f, 0.f, 0.f};
        const bf16_t* wg = (const bf16_t*)(ws + OFF_WGLU + l * SZ_WGLU) + (size_t)(wid * 64 + fr) * 512 + fq * 8;
#pragma unroll 4
        for (int kk = 0; kk < 16; ++kk) {
            bf16x8 af[2], bf[4];
#pragma unroll
            for (int nt = 0; nt < 4; ++nt) bf[nt] = *(const bf16x8*)(wg + (size_t)nt * 16 * 512 + kk * 32);
#pragma unroll
            for (int mt = 0; mt < 2; ++mt) af[mt] = *(const bf16x8*)(gtile + (mt * 16 + fr) * 520 + kk * 32 + fq * 8);
#pragma unroll
            for (int mt = 0; mt < 2; ++mt)
#pragma unroll
                for (int nt = 0; nt < 4; ++nt) acc[mt][nt] = __builtin_amdgcn_mfma_f32_16x16x32_bf16(af[mt], bf[nt], acc[mt][nt], 0, 0, 0);
        }
        float o[2][4][4];
#pragma unroll
        for (int mt = 0; mt < 2; ++mt)
#pragma unroll
            for (int nt = 0; nt < 4; ++nt) { const int n = wid * 64 + nt * 16 + fr; const float bg = P.in[24][l * 512 + n];
#pragma unroll
                for (int r = 0; r < 4; ++r) o[mt][nt][r] = bf2f(gtile[(mt * 16 + fq * 4 + r) * 520 + n]) * sigm(acc[mt][nt][r] + bg); }
        __syncthreads();
#pragma unroll
        for (int mt = 0; mt < 2; ++mt)
#pragma unroll
            for (int nt = 0; nt < 4; ++nt)
#pragma unroll
                for (int r = 0; r < 4; ++r) gtile[(mt * 16 + fq * 4 + r) * 520 + wid * 64 + nt * 16 + fr] = f2bf(o[mt][nt][r]);
        __syncthreads();
        norm_store(gtile, MIX + (size_t)row0 * 1024 + 512);
    }
}

__device__ __forceinline__ void carry_phase(const Params& P, int l, unsigned char* lds) {
    unsigned char* ws = P.ws; const int tid = opaque_tid();
    for (int it = blockIdx.x; it < 13; it += gridDim.x) {
        if (it == 0) {
            const float* A = (const float*)(ws + OFF_LRUA); const float* B = (const float*)(ws + OFF_LRUB); float* C = (float*)(ws + OFF_LRUC); float cs = 0.f;
#pragma unroll 8
            for (int k = 0; k < NPT; ++k) { C[(size_t)k * 512 + tid] = cs; cs = A[(size_t)k * 512 + tid] * cs + B[(size_t)k * 512 + tid]; }
        } else if (it <= 4) {
            const int idx = (it - 1) * 512 + tid; const float* lb = (const float*)(ws + OFF_LB) + (size_t)l * 4 * 2048; const float qr = lb[4096 + idx], qi = lb[6144 + idx];
            const float* E = (const float*)(ws + OFF_S5E); float* C = (float*)(ws + OFF_S5C); float xr = 0.f, xi = 0.f;
#pragma unroll 8
            for (int k = 0; k < NPT; ++k) { C[(size_t)k * 4096 + idx] = xr; C[(size_t)k * 4096 + 2048 + idx] = xi; const float er = E[(size_t)k * 4096 + idx], ei = E[(size_t)k * 4096 + 2048 + idx];
                const float nr = qr * xr - qi * xi + er, ni = qr * xi + qi * xr + ei; xr = nr; xi = ni; }
        } else mixer_tile<true>(P, l, NPT + it - 5, lds);
    }
}

__device__ __forceinline__ void final_norm(const Params& P) {
    const float* ss = (const float*)(P.ws + OFF_SS) + 4 * TT;
    for (int i = blockIdx.x * 512 + opaque_tid(); i < TT * 256; i += gridDim.x * 512) { const int row = i >> 8, c4 = (i & 255) * 4; const float rs = rsqrtf(ss[row] * (1.f / 1024.f) + EPS);
        float4 v = *(float4*)(P.out + (size_t)row * 1024 + c4); const float4 g = *(const float4*)(P.in[32] + c4); v.x *= rs * g.x; v.y *= rs * g.y; v.z *= rs * g.z; v.w *= rs * g.w;
        *(float4*)(P.out + (size_t)row * 1024 + c4) = v; }
}

__global__ void __launch_bounds__(512, 2) hymba_fwd(Params P) {
    extern __shared__ __attribute__((aligned(16))) unsigned char shm[];
    cg::grid_group grid = cg::this_grid();
    unsigned char* ws = P.ws;
    float* ss = (float*)(ws + OFF_SS);
    bf16_t* XB = (bf16_t*)(ws + OFF_XB);
    prep_phase(P, shm);
    grid.sync();
    for (int l = 0; l < 2; ++l) {
        run_gemm(shm, XB, (const bf16_t*)(ws + OFF_WIN + l * SZ_WIN), TT, INW, DM, EpiZ{(bf16_t*)(ws + OFF_Z), ss + (size_t)(2 * l) * TT});
        grid.sync();
        for (int t = blockIdx.x; t < NPT; t += gridDim.x) mixer_tile<false>(P, l, t, shm);
        grid.sync();
        carry_phase(P, l, shm);
        grid.sync();
        for (int t = blockIdx.x; t < NPT; t += gridDim.x) mixer_tile<true>(P, l, t, shm);
        grid.sync();
        run_gemm(shm, (const bf16_t*)(ws + OFF_MIX), (const bf16_t*)(ws + OFF_WOUT + l * SZ_WOUT), TT, DM, DM,
                 EpiRes{l == 0 ? P.in[0] : P.out, l == 0 ? P.in[1] : P.out + (size_t)TP * 1024, P.out, XB, ss + (size_t)(2 * l + 1) * TT});
        grid.sync();
        run_gemm(shm, XB, (const bf16_t*)(ws + OFF_WGU + l * SZ_WGU), TT, NGU, DM, EpiFF{(bf16_t*)(ws + OFF_FF), ss + (size_t)(2 * l + 1) * TT});
        grid.sync();
        run_gemm(shm, (const bf16_t*)(ws + OFF_FF), (const bf16_t*)(ws + OFF_WDN + l * SZ_WDN), TT, DM, DFF,
                 EpiRes{P.out, P.out + (size_t)TP * 1024, P.out, XB, ss + (size_t)(2 * l + 2) * TT});
        grid.sync();
    }
    final_norm(P);
}

extern "C" void kernel_launch(void* const* d_in, const int* in_sizes, int n_in, void* d_out, int out_size, void* d_ws, size_t ws_size, hipStream_t stream) {
    static int grid = 0;
    if (grid == 0) {
        if (n_in != 33 || ws_size < WS_END) { fprintf(stderr, "kernel_launch: expected 33 inputs and >= %zu bytes of workspace (got %d, %zu)\n", (size_t)WS_END, n_in, ws_size); grid = -1; return; }
        int dev = 0, cus = 0, per_cu = 0;
        hipGetDevice(&dev); hipDeviceGetAttribute(&cus, hipDeviceAttributeMultiprocessorCount, dev);
        if (hipFuncSetAttribute((const void*)hymba_fwd, hipFuncAttributeMaxDynamicSharedMemorySize, LDS_BYTES) != hipSuccess) { fprintf(stderr, "kernel_launch: hipFuncSetAttribute failed\n"); grid = -1; return; }
        if (hipOccupancyMaxActiveBlocksPerMultiprocessor(&per_cu, (const void*)hymba_fwd, 512, LDS_BYTES) != hipSuccess || per_cu < 1) { fprintf(stderr, "kernel_launch: occupancy query gave %d\n", per_cu); per_cu = 1; }
        (void)hipGetLastError();
        grid = cus * per_cu;
    }
    if (grid < 0) return;
    Params p{};
    for (int i = 0; i < 33; ++i) p.in[i] = (const float*)d_in[i];
    p.out = (float*)d_out; p.ws = (unsigned char*)d_ws;
    void* args[] = {&p};
    hipError_t e = hipLaunchCooperativeKernel((const void*)hymba_fwd, dim3(grid), dim3(512), args, LDS_BYTES, stream);
    if (e != hipSuccess) fprintf(stderr, "cooperative launch failed: %s (grid %d)\n", hipGetErrorString(e), grid);
}
```

```cpp
#include <hip/hip_runtime.h>
#include <hip/hip_cooperative_groups.h>
#include <cstdio>
namespace cg = cooperative_groups;

namespace pg8 {
#define PG8_LAS __attribute__((address_space(3)))
typedef unsigned short bf16_t;
typedef short bf16x8 __attribute__((ext_vector_type(8)));
typedef float f32x4 __attribute__((ext_vector_type(4)));
typedef unsigned u32x4 __attribute__((ext_vector_type(4)));
constexpr int BM = 256, BK = 64, HALF = 128, HTB = HALF * BK * 2  , STAGE_BYTES = 8 * HTB, NXCD = 8, WGM = 8;

__host__ __device__ __forceinline__ int lds_byte(int r, int c) { const int st = (r >> 4) * 2 + (c >> 5), rr = r & 15, cc = c & 31, ob = rr * 64 + cc * 2; return st * 1024 + (ob ^ (((ob >> 9) & 1) << 5)); }
__host__ __device__ __forceinline__ void stage_rc(int b, int& R, int& C) { const int st = b / 1024, sb = b % 1024, swz = sb ^ (((sb >> 9) & 1) << 5); R = (st >> 1) * 16 + swz / 64; C = (st & 1) * 32 + (swz % 64) / 2; }
__host__ __device__ __forceinline__ int perm32(int rho) { const int n = rho >> 4, i = rho & 15; return 8 * (i >> 2) + 4 * n + (i & 3); }

struct Unit { int pm, pn, k0t, nt, part; };
struct Gemm { const bf16_t* A; const bf16_t* Bt; int M, N, K; };

struct StaticOrder {
    int nM, nN, nwg, G, c, ntfull;
    __host__ __device__ void init(int M, int N, int G_, int c_) { nM = M / BM; nN = N / BM; nwg = nM * nN; G = G_; c = c_; ntfull = 0; }
    __host__ __device__ bool next(int i, Unit& u) const {
        const long L = (long)i * G + c; if (L >= nwg) return false;
        int wgid = (int)L; { const int q = nwg / NXCD, r = nwg % NXCD, xcd = wgid % NXCD, off = wgid / NXCD; wgid = (xcd < r ? xcd * (q + 1) : r * (q + 1) + (xcd - r) * q) + off; }
        const int nig = WGM * nN, gid = wgid / nig, fm = gid * WGM, gsz = (nM - fm) < WGM ? (nM - fm) : WGM;
        u.pm = fm + ((wgid % nig) % gsz); u.pn = (wgid % nig) / gsz; u.k0t = 0; u.nt = ntfull; u.part = 0; return true;
    }
    __device__ __forceinline__ void a_ready(const Unit&) const {}
    __device__ __forceinline__ void done(const Unit&) const {}
};
__device__ __forceinline__ unsigned cvt_pk_bf16(float lo, float hi) { unsigned r; asm volatile("v_cvt_pk_bf16_f32 %0, %1, %2" : "=v"(r) : "v"(lo), "v"(hi)); return r; }
template <class Epi, class Sched, bool STAMP = false>
__device__ __forceinline__ void gemm_phase(PG8_LAS unsigned char* lds, const Gemm g, const Sched& S, const Epi& E, unsigned long long* stamps) {
    int tid_ = threadIdx.x; asm volatile("" : "+v"(tid_));
    const int tid = tid_, wid = __builtin_amdgcn_readfirstlane(tid >> 6), lane = tid & 63, wr = wid >> 2, wc = wid & 3, fr = lane & 15, fq = lane >> 4;
    const int K = g.K;
    int ts_lo = 0, ts_hi = 0, nts = 0; const unsigned long long rt_entry = STAMP ? (unsigned long long)wall_clock64() : 0ull;
#define PG8_STAMP() do { if (STAMP && wid == 0 && nts < 64) { const unsigned long long _c = (unsigned long long)clock64(); \
        ts_lo = (lane == nts) ? (int)(unsigned)_c : ts_lo; ts_hi = (lane == nts) ? (int)(unsigned)(_c >> 32) : ts_hi; ++nts; } } while (0)
    PG8_STAMP();
    unsigned voffA[2], voffB[2];
#pragma unroll
    for (int i = 0; i < 2; ++i) { int R, C; stage_rc(tid * 16 + i * 8192, R, C); const int Rb = Epi::PERM ? ((R & ~31) + perm32(R & 31)) : R;
        voffA[i] = (unsigned)(R * K + C) * 2u; voffB[i] = (unsigned)(Rb * K + C) * 2u; }
    const size_t kstep = (size_t)(BK * 2);
    const size_t hstep = (size_t)HALF * K * 2;
    const size_t tstep = 2 * hstep;
    const unsigned ldsw = (unsigned)wid * 1024u;
    const int aoff = lds_byte(wr * 64 + fr, fq * 8), boff = lds_byte(wc * 32 + fr, fq * 8);
#define PG8_SA(b, h) (((b) * 2 + (h)) * HTB)
#define PG8_SB(b, h) ((4 + (b) * 2 + (h)) * HTB)
#define PG8_STAGE(bufoff, gbase, voff) do { _Pragma("unroll") for (int _i = 0; _i < 2; ++_i) \
        __builtin_amdgcn_global_load_lds((const unsigned*)((const char*)(gbase) + (voff)[_i]), (PG8_LAS unsigned*)(lds + (bufoff) + ldsw + _i * 8192), 16, 0, 0); } while (0)
#define PG8_LDA(dst, b, h) do { _Pragma("unroll") for (int m = 0; m < 4; ++m) _Pragma("unroll") for (int k = 0; k < 2; ++k) dst[m][k] = *(const PG8_LAS bf16x8*)(lds + PG8_SA(b, h) + aoff + m * 2048 + k * 1024); } while (0)
#define PG8_LDB(dst, b, h) do { _Pragma("unroll") for (int n = 0; n < 2; ++n) _Pragma("unroll") for (int k = 0; k < 2; ++k) dst[n][k] = *(const PG8_LAS bf16x8*)(lds + PG8_SB(b, h) + boff + n * 2048 + k * 1024); } while (0)
#define PG8_MMA(ai, bj, At, Bt) do { __builtin_amdgcn_s_setprio(1); _Pragma("unroll") for (int m = 0; m < 4; ++m) _Pragma("unroll") for (int n = 0; n < 2; ++n) _Pragma("unroll") for (int k = 0; k < 2; ++k) \
        acc[ai][bj][m][n] = __builtin_amdgcn_mfma_f32_16x16x32_bf16(Bt[n][k], At[m][k], acc[ai][bj][m][n], 0, 0, 0); __builtin_amdgcn_s_setprio(0); } while (0)
#define PG8_WAIT_V(n) asm volatile("s_waitcnt vmcnt(" #n ")" ::: "memory")
#define PG8_WAIT_L(n) asm volatile("s_waitcnt lgkmcnt(" #n ")" ::: "memory")
#define PG8_BAR __builtin_amdgcn_s_barrier()
#define PG8_SCHED __builtin_amdgcn_sched_barrier(0)
    Unit cur, nxt; int ui = 0;
    if (!S.next(0, cur)) return;
    f32x4 acc[2][2][4][2];
#pragma unroll
    for (int a = 0; a < 2; ++a)
#pragma unroll
        for (int b = 0; b < 2; ++b)
#pragma unroll
            for (int m = 0; m < 4; ++m)
#pragma unroll
                for (int n = 0; n < 2; ++n) acc[a][b][m][n] = (f32x4){0.f, 0.f, 0.f, 0.f};
    bf16x8 At[4][2], B0[2][2], B1[2][2];
    const char* cA = (const char*)g.A + (size_t)cur.pm * tstep + (size_t)cur.k0t * kstep; const char* cB = (const char*)g.Bt + (size_t)cur.pn * tstep + (size_t)cur.k0t * kstep;
    S.a_ready(cur);
    PG8_STAGE(PG8_SB(0, 0), cB, voffB); PG8_STAGE(PG8_SA(0, 0), cA, voffA); PG8_STAGE(PG8_SB(0, 1), cB + hstep, voffB); PG8_STAGE(PG8_SA(0, 1), cA + hstep, voffA);
    if (wr == 1) PG8_BAR;
    PG8_WAIT_V(4); PG8_BAR;
    PG8_STAGE(PG8_SB(1, 0), cB + kstep, voffB); PG8_STAGE(PG8_SA(1, 0), cA + kstep, voffA); PG8_STAGE(PG8_SB(1, 1), cB + hstep + kstep, voffB);
    PG8_WAIT_V(6); PG8_BAR;
    PG8_STAMP();
    for (;;) {
        const bool has_next = S.next(ui + 1, nxt);
        const char* nA = has_next ? (const char*)g.A + (size_t)nxt.pm * tstep + (size_t)nxt.k0t * kstep : cA; const char* nB = has_next ? (const char*)g.Bt + (size_t)nxt.pn * tstep + (size_t)nxt.k0t * kstep : cB;
        const int nt = cur.nt;
        for (int t = 0; t < nt; t += 2) {
            const bool last = (t == nt - 2);
            const char* a1 = cA + (size_t)(t + 1) * kstep;
            const char* a2 = last ? nA : cA + (size_t)(t + 2) * kstep; const char* b2 = last ? nB : cB + (size_t)(t + 2) * kstep;
            const char* a3 = a2 + kstep; const char* b3 = b2 + kstep;
            if (last && has_next) S.a_ready(nxt);
            PG8_LDB(B0, 0, 0); PG8_SCHED; PG8_LDA(At, 0, 0); PG8_STAGE(PG8_SA(1, 1), a1 + hstep, voffA);
            PG8_WAIT_L(8); PG8_BAR; PG8_WAIT_L(0); PG8_MMA(0, 0, At, B0); PG8_BAR; PG8_SCHED;
            PG8_LDB(B1, 0, 1); PG8_STAGE(PG8_SB(0, 0), b2, voffB);
            PG8_BAR; PG8_WAIT_L(0); PG8_MMA(0, 1, At, B1); PG8_BAR;
            PG8_LDA(At, 0, 1); PG8_STAGE(PG8_SA(0, 0), a2, voffA);
            PG8_BAR; PG8_WAIT_L(0); PG8_MMA(1, 0, At, B0); PG8_BAR; PG8_SCHED;
            PG8_STAGE(PG8_SB(0, 1), b2 + hstep, voffB);
            PG8_WAIT_V(6); PG8_BAR; PG8_MMA(1, 1, At, B1); PG8_BAR;
            PG8_LDB(B0, 1, 0); PG8_SCHED; PG8_LDA(At, 1, 0); PG8_STAGE(PG8_SA(0, 1), a2 + hstep, voffA);
            PG8_WAIT_L(8); PG8_BAR; PG8_WAIT_L(0); PG8_MMA(0, 0, At, B0); PG8_BAR; PG8_SCHED;
            PG8_LDB(B1, 1, 1); PG8_STAGE(PG8_SB(1, 0), b3, voffB);
            PG8_BAR; PG8_WAIT_L(0); PG8_MMA(0, 1, At, B1); PG8_BAR;
            PG8_LDA(At, 1, 1); PG8_STAGE(PG8_SA(1, 0), a3, voffA);
            PG8_BAR; PG8_WAIT_L(0); PG8_MMA(1, 0, At, B0); PG8_BAR; PG8_SCHED;
            PG8_STAGE(PG8_SB(1, 1), b3 + hstep, voffB);
            PG8_WAIT_V(6); PG8_BAR; PG8_MMA(1, 1, At, B1); PG8_BAR;
        }
        PG8_STAMP();
        if constexpr (!Epi::AFTER_DRAIN) { E(acc, cur, wr, wc, fr, fq); S.done(cur); }
        PG8_STAMP();
        if (!has_next) break;
#pragma unroll
        for (int a = 0; a < 2; ++a)
#pragma unroll
            for (int b = 0; b < 2; ++b)
#pragma unroll
                for (int m = 0; m < 4; ++m)
#pragma unroll
                    for (int n = 0; n < 2; ++n) acc[a][b][m][n] = (f32x4){0.f, 0.f, 0.f, 0.f};
        cur = nxt; cA = nA; cB = nB; ++ui;
    }
    PG8_WAIT_V(0);
    if (wr == 0) PG8_BAR;
    PG8_BAR;
    if constexpr (Epi::AFTER_DRAIN) { E.fused(acc, cur, wr, wc, fr, fq, lds, wid, lane); S.done(cur); }
    PG8_STAMP();
    if (STAMP && wid == 0) { stamps[lane] = lane < nts ? (((unsigned long long)(unsigned)ts_hi << 32) | (unsigned)ts_lo) : 0ull;
        if (lane == 62) stamps[62] = rt_entry; if (lane == 63) stamps[63] = (unsigned long long)wall_clock64(); }
#undef PG8_STAMP
#undef PG8_SA
#undef PG8_SB
#undef PG8_STAGE
#undef PG8_LDA
#undef PG8_LDB
#undef PG8_MMA
#undef PG8_WAIT_V
#undef PG8_WAIT_L
#undef PG8_BAR
#undef PG8_SCHED
}
}
#define XB_TMO      128
#define XB_XCNT(j)  (256  + 64 * (j))
#define XB_XSUB(j)  (1280 + 64 * (j))
#define XB_XGEN(j)  (2304 + 64 * (j))
#define XB_TOP      3328
#define XB_TOPGEN   3392
#define XCD_BAR_WORDS 3456
#define XB_SPIN_CAP (1u << 18)
#define LAS __attribute__((address_space(3)))

__device__ __forceinline__ unsigned xb_ld(unsigned* p)              { return __hip_atomic_load(p, __ATOMIC_RELAXED, __HIP_MEMORY_SCOPE_AGENT); }
__device__ __forceinline__ unsigned xb_add(unsigned* p, unsigned v) { return __hip_atomic_fetch_add(p, v, __ATOMIC_RELAXED, __HIP_MEMORY_SCOPE_AGENT); }
__device__ __forceinline__ unsigned xb_xcc_id() { return (unsigned)__builtin_amdgcn_s_getreg((3 << 11) | 20) & 0xFu; }
#define XB_SPIN(cond, bar) do { unsigned _sp = 0; while (cond) { __builtin_amdgcn_s_sleep(1); \
    if ((++_sp & 255u) == 0u) { if (xb_ld(&(bar)[XB_TMO])) break; if (_sp > XB_SPIN_CAP) { atomicAdd(&(bar)[XB_TMO], 1u); break; } } } } while (0)

struct XcdBarrier {
    unsigned* bar; unsigned x;
    volatile LAS unsigned* st;
};

__device__ __forceinline__ XcdBarrier xcd_barrier_post(unsigned* bar, volatile LAS unsigned* st) {
    XcdBarrier b; b.bar = bar; b.x = xb_xcc_id(); b.st = st;
    if (threadIdx.x == 0) (void)xb_add(&bar[XB_XCNT(b.x)], 1u);
    return b;
}
__device__ __forceinline__ void xcd_barrier_complete(unsigned* bar, unsigned x, unsigned& nloc, unsigned& nx) {
    const unsigned G = gridDim.x * gridDim.y * gridDim.z;
    unsigned sum, cnt, mine, sp = 0u;
    for (;;) {
        sum = 0u; cnt = 0u; mine = 0u;
#pragma unroll
        for (unsigned j = 0; j < 16; ++j) { const unsigned c = xb_ld(&bar[XB_XCNT(j)]); sum += c; cnt += (c > 0u) ? 1u : 0u; mine = (j == x) ? c : mine; }
        if (sum == G) break;
        __builtin_amdgcn_s_sleep(1);
        if ((++sp & 255u) == 0u) { if (xb_ld(&bar[XB_TMO])) break; if (sp > XB_SPIN_CAP) { atomicAdd(&bar[XB_TMO], 1u); break; } }
    }
    nloc = mine > 0u ? mine : 1u; nx = cnt > 0u ? cnt : 1u;
}

__device__ __forceinline__ void xcd_barrier(const XcdBarrier& b) {
    asm volatile("s_waitcnt vmcnt(0)" ::: "memory");
    __syncthreads();
    if (threadIdx.x == 0) {
        unsigned* bar = b.bar;
        __builtin_amdgcn_s_waitcnt(0);
        unsigned nloc = b.st[0], nx = b.st[1];
        if (nloc == 0u) { xcd_barrier_complete(bar, b.x, nloc, nx); b.st[0] = nloc; b.st[1] = nx; }
        const unsigned old = xb_add(&bar[XB_XSUB(b.x)], 1u);
        const unsigned gen = old / nloc;
        if (old + 1u == (gen + 1u) * nloc) {
            __builtin_amdgcn_fence(__ATOMIC_RELEASE, "agent");
            asm volatile("s_waitcnt vmcnt(0)" ::: "memory");
            const unsigned og = xb_add(&bar[XB_TOP], 1u);
            const unsigned tg = og / nx;
            if (og + 1u == (tg + 1u) * nx) xb_add(&bar[XB_TOPGEN], 1u);
            else XB_SPIN(xb_ld(&bar[XB_TOPGEN]) == tg, bar);
            __builtin_amdgcn_fence(__ATOMIC_ACQUIRE, "agent");
            xb_add(&bar[XB_XGEN(b.x)], 1u);
            asm volatile("s_waitcnt vmcnt(0)" ::: "memory");
        } else {
            XB_SPIN(xb_ld(&bar[XB_XGEN(b.x)]) == gen, bar);
            __builtin_amdgcn_fence(__ATOMIC_ACQUIRE, "agent");
            asm volatile("s_waitcnt vmcnt(0)" ::: "memory");
        }
    }
    __syncthreads();
}


using pg8::bf16_t; using pg8::bf16x8; using pg8::f32x4; using pg8::Unit;
typedef short bf16x4 __attribute__((ext_vector_type(4)));
typedef unsigned u32x4 __attribute__((ext_vector_type(4)));
typedef unsigned u32x2 __attribute__((ext_vector_type(2)));

constexpr int TP = 16384, TT = 16640, DM = 1024, INW = 1536, DFF = 2816, NGU = 5632;
constexpr int NPT = 512;
constexpr float EPS = 1e-6f;

constexpr size_t SZ_WIN = (size_t)1536 * 1024 * 2, SZ_WOUT = (size_t)1024 * 1024 * 2, SZ_WGU = (size_t)5632 * 1024 * 2, SZ_WDN = (size_t)1024 * 2816 * 2,
                 SZ_WGLU = (size_t)512 * 512 * 2, SZ_WAX = (size_t)2 * 8 * 64 * 64 * 2;
constexpr size_t OFF_WIN = 0;
constexpr size_t OFF_WOUT = OFF_WIN + 2 * SZ_WIN;
constexpr size_t OFF_WGU = OFF_WOUT + 2 * SZ_WOUT;
constexpr size_t OFF_WDN = OFF_WGU + 2 * SZ_WGU;
constexpr size_t OFF_WGLU = OFF_WDN + 2 * SZ_WDN;
constexpr size_t OFF_WAX = OFF_WGLU + 2 * SZ_WGLU;
constexpr size_t OFF_BB = OFF_WAX + 2 * SZ_WAX;
constexpr size_t OFF_CM = OFF_BB + (size_t)2 * 32 * 128 * 16 * 2;
constexpr size_t OFF_LB = OFF_CM + (size_t)2 * 32 * 16 * 128 * 2;
constexpr size_t OFF_SS = OFF_LB + (size_t)2 * 4 * 2048 * 4;
constexpr size_t OFF_LRUA = OFF_SS + (size_t)5 * TT * 4;
constexpr size_t OFF_LRUB = OFF_LRUA + (size_t)NPT * 512 * 4;
constexpr size_t OFF_LRUC = OFF_LRUB + (size_t)NPT * 512 * 4;
constexpr size_t OFF_S5E = OFF_LRUC + (size_t)NPT * 512 * 4;
constexpr size_t OFF_S5C = OFF_S5E + (size_t)NPT * 2 * 2048 * 4;
constexpr size_t OFF_XB = OFF_S5C + (size_t)NPT * 2 * 2048 * 4;
constexpr size_t OFF_R = OFF_XB + (size_t)TT * 1024 * 2;
constexpr size_t OFF_Z = OFF_R, OFF_MIX = OFF_R + (size_t)TT * 1536 * 2, OFF_FF = OFF_R;
constexpr size_t OFF_BAR = OFF_R + (size_t)TT * 2816 * 2;
constexpr size_t OFF_PART = OFF_BAR + 16384;
constexpr size_t OFF_HL = OFF_PART + (size_t)11 * 256 * 1024 * 4;
constexpr size_t OFF_PL = OFF_HL + (size_t)TP * 512 * 2;
constexpr size_t WS_END = OFF_PL + (size_t)TP * 512 * 2;

constexpr size_t O_Y = 0, O_CONV_P = (size_t)TT * 1024, O_LRU_P = O_CONV_P + 3072, O_RE_P = O_LRU_P + 1024, O_IM_P = O_RE_P + 4096,
                 O_CONV_S = O_IM_P + 4096, O_LRU_S = O_CONV_S + 24576, O_RE_S = O_LRU_S + 8192, O_IM_S = O_RE_S + 32768;

constexpr int LDS_GT = 32 * 520 * 2;
constexpr int LDS_RA = 10240;
constexpr int LDS_WSC = LDS_RA + 4352;
constexpr int LDS_BYTES = 150528;
constexpr int LDS_XB = LDS_BYTES - 16;

struct Params { const float* in[33]; float* out; unsigned char* ws; };

__device__ __forceinline__ unsigned pk_bf16(float lo, float hi) { unsigned r; asm("v_cvt_pk_bf16_f32 %0, %1, %2" : "=v"(r) : "v"(lo), "v"(hi)); return r; }
__device__ __forceinline__ bf16_t f2bf(float f) { return (bf16_t)pk_bf16(f, f); }
__device__ __forceinline__ float bf2f(bf16_t b) { return __uint_as_float(((unsigned)b) << 16); }
__device__ __forceinline__ float sigm(float x) { return __builtin_amdgcn_rcpf(1.f + __expf(-x)); }
__device__ __forceinline__ float gelu_t(float x) { return x * sigm(1.5957691216057308f * (x + 0.044715f * x * x * x)); }
__device__ __forceinline__ int opaque_tid() { int t = threadIdx.x; asm volatile("" : "+v"(t)); return t; }
#define WAVE_SYNC() do { __builtin_amdgcn_fence(__ATOMIC_RELEASE, "wavefront"); __builtin_amdgcn_wave_barrier(); __builtin_amdgcn_fence(__ATOMIC_ACQUIRE, "wavefront"); } while (0)

struct EpiZ {
    static constexpr bool PERM = true, AFTER_DRAIN = false;
    bf16_t* O; const float* ss;
    __device__ __forceinline__ void operator()(const f32x4 (&acc)[2][2][4][2], const Unit& u, int wr, int wc, int fr, int fq) const {
        const int row0 = u.pm * 256 + wr * 64 + fr, col0 = u.pn * 256 + wc * 32 + 8 * fq;
        float rs[2][4];
#pragma unroll
        for (int ai = 0; ai < 2; ++ai)
#pragma unroll
            for (int m = 0; m < 4; ++m) rs[ai][m] = ss[row0 + ai * 128 + m * 16];
#pragma unroll
        for (int ai = 0; ai < 2; ++ai)
#pragma unroll
            for (int m = 0; m < 4; ++m) {
                const int row = row0 + ai * 128 + m * 16; const float r1 = rsqrtf(rs[ai][m] * (1.f / 1024.f) + EPS);
                bf16_t* rp = O + (size_t)row * INW + col0;
#pragma unroll
                for (int bj = 0; bj < 2; ++bj) { const f32x4 v0 = acc[ai][bj][m][0] * r1, v1 = acc[ai][bj][m][1] * r1;
                    u32x4 pk; pk[0] = pk_bf16(v0[0], v0[1]); pk[1] = pk_bf16(v0[2], v0[3]); pk[2] = pk_bf16(v1[0], v1[1]); pk[3] = pk_bf16(v1[2], v1[3]);
                    *(u32x4*)(rp + bj * 128) = pk; }
            }
    }
};
struct EpiFF {
    static constexpr bool PERM = true, AFTER_DRAIN = false;
    bf16_t* O; const float* ss;
    __device__ __forceinline__ void operator()(const f32x4 (&acc)[2][2][4][2], const Unit& u, int wr, int wc, int fr, int fq) const {
        const int row0 = u.pm * 256 + wr * 64 + fr, f0 = u.pn * 128 + wc * 32 + 8 * fq;
        float rs[2][4];
#pragma unroll
        for (int ai = 0; ai < 2; ++ai)
#pragma unroll
            for (int m = 0; m < 4; ++m) rs[ai][m] = ss[row0 + ai * 128 + m * 16];
#pragma unroll
        for (int ai = 0; ai < 2; ++ai)
#pragma unroll
            for (int m = 0; m < 4; ++m) {
                const int row = row0 + ai * 128 + m * 16; const float r1 = rsqrtf(rs[ai][m] * (1.f / 1024.f) + EPS), r2 = r1 * -1.4426950408889634f;
                float o[8];
#pragma unroll
                for (int n = 0; n < 2; ++n)
#pragma unroll
                    for (int i = 0; i < 4; ++i) { const float ag = acc[ai][0][m][n][i];
                        o[n * 4 + i] = (ag * r1) * (acc[ai][1][m][n][i] * r1) * __builtin_amdgcn_rcpf(1.f + __builtin_amdgcn_exp2f(ag * r2)); }
                u32x4 pk; pk[0] = pk_bf16(o[0], o[1]); pk[1] = pk_bf16(o[2], o[3]); pk[2] = pk_bf16(o[4], o[5]); pk[3] = pk_bf16(o[6], o[7]);
                *(u32x4*)(O + (size_t)row * DFF + f0) = pk;
            }
    }
};
struct EpiRes {
    static constexpr bool PERM = true, AFTER_DRAIN = false;
    bf16_t* xb; float* ss; float* part;
    __device__ __forceinline__ void operator()(const f32x4 (&acc)[2][2][4][2], const Unit& u, int wr, int wc, int fr, int fq) const {
        const int row0 = u.pm * 256 + wr * 64 + fr, col0 = u.pn * 256 + wc * 32 + 8 * fq;
        if (u.part) {
            float* pb = part + ((size_t)(u.k0t / u.nt) * 256 + (wr * 64 + fr)) * 1024 + col0;
#pragma unroll
            for (int ai = 0; ai < 2; ++ai)
#pragma unroll
                for (int m = 0; m < 4; ++m) { float* op = pb + (size_t)(ai * 128 + m * 16) * 1024;
#pragma unroll
                    for (int bj = 0; bj < 2; ++bj)
#pragma unroll
                        for (int n = 0; n < 2; ++n) *(f32x4*)(op + bj * 128 + 4 * n) = acc[ai][bj][m][n]; }
            return;
        }
#pragma unroll
        for (int ai = 0; ai < 2; ++ai) {
            u32x4 xv[4][2];
#pragma unroll
            for (int m = 0; m < 4; ++m)
#pragma unroll
                for (int bj = 0; bj < 2; ++bj) xv[m][bj] = *(const u32x4*)(xb + (size_t)(row0 + ai * 128 + m * 16) * 1024 + col0 + bj * 128);
#pragma unroll
            for (int m = 0; m < 4; ++m) {
                const int row = row0 + ai * 128 + m * 16; bf16_t* bp = xb + (size_t)row * 1024 + col0; float sq = 0.f;
#pragma unroll
                for (int bj = 0; bj < 2; ++bj) { const u32x4 w = xv[m][bj]; u32x4 pk;
#pragma unroll
                    for (int n = 0; n < 2; ++n) { const f32x4 a = acc[ai][bj][m][n];
                        const float v0 = __uint_as_float(w[2 * n] << 16) + a[0], v1 = __uint_as_float(w[2 * n] & 0xFFFF0000u) + a[1], v2 = __uint_as_float(w[2 * n + 1] << 16) + a[2], v3 = __uint_as_float(w[2 * n + 1] & 0xFFFF0000u) + a[3];
                        pk[2 * n] = pk_bf16(v0, v1); pk[2 * n + 1] = pk_bf16(v2, v3); sq += v0 * v0 + v1 * v1 + v2 * v2 + v3 * v3; }
                    *(u32x4*)(bp + bj * 128) = pk; }
                sq += __shfl_xor(sq, 16); sq += __shfl_xor(sq, 32);
                if (fq == 0) atomicAdd(ss + row, sq);
            }
        }
    }
};
struct SplitOrder : pg8::StaticOrder {
    int nwgP, nsplit, ntS, nNs;
    __device__ __forceinline__ void init2(int N, int K, int G_, int c_, int nsplit_) { init(TP, N, G_, c_); ntfull = K / 64; nwgP = nwg; nNs = N / 256; nsplit = nsplit_; ntS = ntfull / nsplit_; }
    __device__ __forceinline__ bool next(int i, Unit& u) const {
        const long L = (long)i * G + c;
        if (L < nwgP) return pg8::StaticOrder::next(i, u);
        const int sidx = (int)(L - nwgP); if (sidx >= nNs * nsplit) return false;
        u.pm = 64; u.pn = sidx % nNs; u.k0t = (sidx / nNs) * ntS; u.nt = ntS; u.part = 1; return true;
    }
};
__device__ __forceinline__ void sample_fix(const Params& P, int nsplit, float* ss_out, unsigned* ctr) {
    const int tid = opaque_tid(), wid = tid >> 6, lane = tid & 63; const float* part = (const float*)(P.ws + OFF_PART);
    for (int r = blockIdx.x * 8 + wid; r < 256; r += gridDim.x * 8) { const int row = TP + r; bf16_t* xb = (bf16_t*)(P.ws + OFF_XB) + (size_t)row * 1024; float sq = 0.f;
        float4 v[4];
#pragma unroll
        for (int j = 0; j < 4; ++j) { const u32x2 w = *(const u32x2*)(xb + j * 256 + lane * 4); v[j].x = __uint_as_float(w[0] << 16); v[j].y = __uint_as_float(w[0] & 0xFFFF0000u); v[j].z = __uint_as_float(w[1] << 16); v[j].w = __uint_as_float(w[1] & 0xFFFF0000u); }
        for (int s0 = 0; s0 < nsplit; s0 += 4) {
            float4 w[4][4];
#pragma unroll
            for (int b = 0; b < 4; ++b) if (s0 + b < nsplit) { const float* pr = part + ((size_t)(s0 + b) * 256 + r) * 1024;
#pragma unroll
                for (int j = 0; j < 4; ++j) w[b][j] = *(const float4*)(pr + j * 256 + lane * 4); }
#pragma unroll
            for (int b = 0; b < 4; ++b) if (s0 + b < nsplit) {
#pragma unroll
                for (int j = 0; j < 4; ++j) { v[j].x += w[b][j].x; v[j].y += w[b][j].y; v[j].z += w[b][j].z; v[j].w += w[b][j].w; } } }
#pragma unroll
        for (int j = 0; j < 4; ++j) { sq += v[j].x * v[j].x + v[j].y * v[j].y + v[j].z * v[j].z + v[j].w * v[j].w;
            u32x2 pk; pk[0] = pk_bf16(v[j].x, v[j].y); pk[1] = pk_bf16(v[j].z, v[j].w); *(u32x2*)(xb + j * 256 + lane * 4) = pk; }
#pragma unroll
        for (int o = 1; o < 64; o <<= 1) sq += __shfl_xor(sq, o);
        if (lane == 0) ss_out[row] = sq;
        __builtin_amdgcn_fence(__ATOMIC_RELEASE, "agent");
        asm volatile("s_waitcnt vmcnt(0)" ::: "memory");
        if (lane == 0) __hip_atomic_fetch_add(ctr, 1u, __ATOMIC_RELAXED, __HIP_MEMORY_SCOPE_AGENT); }
}
constexpr int CTR_WORD0 = 3584;
struct WaitOrder : pg8::StaticOrder {
    const unsigned* ready;
    __device__ __forceinline__ void a_ready(const Unit& u) const {
        if (ready == nullptr || u.pm != 64) return;
        if (threadIdx.x < 64) {
            unsigned polls = 0;
            while ((unsigned)__builtin_amdgcn_readfirstlane((int)__hip_atomic_load(ready, __ATOMIC_RELAXED, __HIP_MEMORY_SCOPE_AGENT)) < 256u) { if (++polls > (1u << 22)) break; __builtin_amdgcn_s_sleep(2); }
            __builtin_amdgcn_fence(__ATOMIC_ACQUIRE, "agent");
            asm volatile("s_waitcnt vmcnt(0)" ::: "memory");
        }
        asm volatile("" ::: "memory"); __builtin_amdgcn_s_barrier(); asm volatile("" ::: "memory");
    }
};
template <class Epi> __device__ __forceinline__ void run_gemm(unsigned char* lds, const bf16_t* A, const bf16_t* Bt, int M, int N, int K, const Epi& E, const unsigned* ready) {
    pg8::Gemm g{A, Bt, M, N, K}; WaitOrder S; S.init(M, N, (int)gridDim.x, (int)blockIdx.x); S.ntfull = K / 64; S.ready = ready;
    pg8::gemm_phase<Epi, WaitOrder, false>((PG8_LAS unsigned char*)lds, g, S, E, nullptr);
}
struct SampleFirstOrder : pg8::StaticOrder {
    const unsigned* ready; unsigned* donectr; int nNs;
    __device__ __forceinline__ void init3(int N, int K, int G_, int c_) { init(TP, N, G_, c_); ntfull = K / 64; nNs = N / 256; }
    __device__ __forceinline__ bool next(int i, Unit& u) const {
        long L = (long)i * G + c; u.k0t = 0; u.nt = ntfull; u.part = 0;
        if (L < nNs) { u.pm = 64; u.pn = (int)L; return true; }
        L -= nNs; if (L >= nwg) return false;
        int wgid = (int)L; { const int q = nwg / pg8::NXCD, r = nwg % pg8::NXCD, xcd = wgid % pg8::NXCD, off = wgid / pg8::NXCD; wgid = (xcd < r ? xcd * (q + 1) : r * (q + 1) + (xcd - r) * q) + off; }
        const int nig = pg8::WGM * nN, gid = wgid / nig, fm = gid * pg8::WGM, gsz = (nM - fm) < pg8::WGM ? (nM - fm) : pg8::WGM;
        u.pm = fm + ((wgid % nig) % gsz); u.pn = (wgid % nig) / gsz; return true;
    }
    __device__ __forceinline__ void a_ready(const Unit& u) const {
        if (ready == nullptr || u.pm != 64) return;
        if (threadIdx.x < 64) {
            unsigned polls = 0;
            while ((unsigned)__builtin_amdgcn_readfirstlane((int)__hip_atomic_load(ready, __ATOMIC_RELAXED, __HIP_MEMORY_SCOPE_AGENT)) < 256u) { if (++polls > (1u << 22)) break; __builtin_amdgcn_s_sleep(2); }
            __builtin_amdgcn_fence(__ATOMIC_ACQUIRE, "agent");
            asm volatile("s_waitcnt vmcnt(0)" ::: "memory");
        }
        asm volatile("" ::: "memory"); __builtin_amdgcn_s_barrier(); asm volatile("" ::: "memory");
    }
    __device__ __forceinline__ void done(const Unit& u) const {
        if (u.pm != 64 || donectr == nullptr) return;
        __builtin_amdgcn_fence(__ATOMIC_RELEASE, "agent"); asm volatile("s_waitcnt vmcnt(0)" ::: "memory");
        if ((threadIdx.x & 63) == 0) __hip_atomic_fetch_add(donectr, 1u, __ATOMIC_RELAXED, __HIP_MEMORY_SCOPE_AGENT);
    }
};
template <class Epi> __device__ __forceinline__ void run_gemm_g1(unsigned char* lds, const bf16_t* A, const bf16_t* Bt, int N, int K, const Epi& E, const unsigned* ready, unsigned* donectr) {
    pg8::Gemm g{A, Bt, TT, N, K}; SampleFirstOrder S; S.init3(N, K, (int)gridDim.x, (int)blockIdx.x); S.ready = ready; S.donectr = donectr;
    pg8::gemm_phase<Epi, SampleFirstOrder, false>((PG8_LAS unsigned char*)lds, g, S, E, nullptr);
}
template <class Epi> __device__ __forceinline__ void run_gemm_sample_split(unsigned char* lds, const bf16_t* A, const bf16_t* Bt, int N, int K, int nsplit, int rank, const Epi& E) {
    pg8::Gemm g{A, Bt, TT, N, K}; SplitOrder S; S.init2(N, K, 1 << 20, rank, nsplit); S.nwgP = 0;
    pg8::gemm_phase<Epi, SplitOrder, false>((PG8_LAS unsigned char*)lds, g, S, E, nullptr);
}
__device__ __forceinline__ void wait_counter(const unsigned* ctr, unsigned need) {
    if (threadIdx.x < 64) {
        unsigned polls = 0;
        while ((unsigned)__builtin_amdgcn_readfirstlane((int)__hip_atomic_load(ctr, __ATOMIC_RELAXED, __HIP_MEMORY_SCOPE_AGENT)) < need) { if (++polls > (1u << 22)) break; __builtin_amdgcn_s_sleep(2); }
        __builtin_amdgcn_fence(__ATOMIC_ACQUIRE, "agent");
        asm volatile("s_waitcnt vmcnt(0)" ::: "memory");
    }
    __syncthreads();
}
template <class Epi> __device__ __forceinline__ void run_gemm_split(unsigned char* lds, const bf16_t* A, const bf16_t* Bt, int N, int K, int nsplit, const Epi& E) {
    pg8::Gemm g{A, Bt, TT, N, K}; SplitOrder S; S.init2(N, K, (int)gridDim.x, (int)blockIdx.x, nsplit);
    pg8::gemm_phase<Epi, SplitOrder, false>((PG8_LAS unsigned char*)lds, g, S, E, nullptr);
}

struct TrTile { const float* src; const float* gain; bf16_t* dst; int N, K, k0, n0, drow; };
__device__ __forceinline__ TrTile tr_decode(const Params& P, int it) {
    unsigned char* ws = P.ws; TrTile t; const int l = it / 2816; int i = it % 2816; int kt, nt;
    if (i < 384) { kt = i / 24; nt = i % 24; t.src = P.in[7] + (size_t)l * 1024 * 1536; t.N = 1536; t.K = 1024; t.gain = P.in[6] + l * 1024 + kt * 64; t.dst = (bf16_t*)(ws + OFF_WIN + l * SZ_WIN); t.drow = nt * 64; }
    else if (i < 640) { i -= 384; kt = i / 16; nt = i % 16; t.src = P.in[27] + (size_t)l * 1024 * 1024; t.N = 1024; t.K = 1024;
        t.gain = kt < 8 ? P.in[25] + l * 512 + kt * 64 : P.in[26] + l * 512 + (kt - 8) * 64; t.dst = (bf16_t*)(ws + OFF_WOUT + l * SZ_WOUT); t.drow = nt * 64; }
    else if (i < 2048) { const bool up = i >= 1344; i -= up ? 1344 : 640; kt = i / 44; nt = i % 44; t.src = (up ? P.in[30] : P.in[29]) + (size_t)l * 1024 * 2816; t.N = 2816; t.K = 1024;
        t.gain = P.in[28] + l * 1024 + kt * 64; t.dst = (bf16_t*)(ws + OFF_WGU + l * SZ_WGU); const int f0 = nt * 64; t.drow = (f0 >> 7) * 256 + (f0 & 127) + (up ? 128 : 0); }
    else if (i < 2752) { i -= 2048; kt = i / 16; nt = i % 16; t.src = P.in[31] + (size_t)l * 2816 * 1024; t.N = 1024; t.K = 2816; t.gain = nullptr; t.dst = (bf16_t*)(ws + OFF_WDN + l * SZ_WDN); t.drow = nt * 64; }
    else { i -= 2752; kt = i / 8; nt = i % 8; t.src = P.in[23] + (size_t)l * 512 * 512; t.N = 512; t.K = 512; t.gain = nullptr; t.dst = (bf16_t*)(ws + OFF_WGLU + l * SZ_WGLU); t.drow = nt * 64; }
    t.k0 = kt * 64; t.n0 = nt * 64; return t;
}

__device__ __forceinline__ void convert_range(const Params& P, int count, int base, int split_at, int jump, int rank, int nblk, unsigned char* lds) {
    float* tile = (float*)lds; const int tid = opaque_tid();
    __syncthreads();
    for (int v0 = rank * 4; v0 < count; v0 += nblk * 4) {
        float4 v[4][2]; float gn[4][2];
#pragma unroll
        for (int j = 0; j < 4; ++j) if (v0 + j < count) { const int vv = v0 + j; const TrTile t = tr_decode(P, base + (vv < split_at ? vv : vv + jump));
#pragma unroll
            for (int i = 0; i < 2; ++i) { const int kk = (tid >> 4) + i * 32, nq = tid & 15; v[j][i] = *(const float4*)(t.src + (size_t)(t.k0 + kk) * t.N + t.n0 + nq * 4); gn[j][i] = t.gain ? t.gain[kk] : 1.f; } }
        __syncthreads();
#pragma unroll
        for (int j = 0; j < 4; ++j) if (v0 + j < count) {
#pragma unroll
            for (int i = 0; i < 2; ++i) { const int kk = (tid >> 4) + i * 32, nq = tid & 15; float* tp = tile + j * 4160 + kk * 65 + nq * 4; const float g = gn[j][i];
                tp[0] = v[j][i].x * g; tp[1] = v[j][i].y * g; tp[2] = v[j][i].z * g; tp[3] = v[j][i].w * g; } }
        __syncthreads();
#pragma unroll
        for (int j = 0; j < 4; ++j) if (v0 + j < count) { const int vv = v0 + j; const TrTile t = tr_decode(P, base + (vv < split_at ? vv : vv + jump)); const int n = tid >> 3, kq = tid & 7; const float* tp = tile + j * 4160 + (kq * 8) * 65 + n;
            u32x4 pk; pk[0] = pk_bf16(tp[0], tp[65]); pk[1] = pk_bf16(tp[130], tp[195]); pk[2] = pk_bf16(tp[260], tp[325]); pk[3] = pk_bf16(tp[390], tp[455]);
            *(u32x4*)(t.dst + (size_t)(t.drow + n) * t.K + t.k0 + kq * 8) = pk; }
    }
    __syncthreads();
}
__device__ __forceinline__ void convert_by_idle(const Params& P, int items, int count, int base, int split_at, int jump, unsigned char* lds) {
    const int G = (int)gridDim.x, c = (int)blockIdx.x; const int first = items < G ? items : items % G;
    if (first == 0 || first >= G) convert_range(P, count, base, split_at, jump, c, G, lds);
    else if (c >= first) convert_range(P, count, base, split_at, jump, c - first, G - first, lds);
}

__device__ __forceinline__ void prep_phase(const Params& P, unsigned char* lds) {
    float* tile = (float*)lds; unsigned char* ws = P.ws;
    const int tid = opaque_tid(), wid = tid >> 6, lane = tid & 63;
    const int gtid = blockIdx.x * 512 + tid, gsz = gridDim.x * 512;
    for (int row0 = blockIdx.x * 8 + wid; row0 < TT; row0 += gridDim.x * 8 * 4) {
        float4 v[4][4];
#pragma unroll
        for (int q = 0; q < 4; ++q) { const int row = row0 + q * gridDim.x * 8; if (row < TT) { const float* xr = row < TP ? P.in[0] + (size_t)row * 1024 : P.in[1] + (size_t)(row - TP) * 1024;
#pragma unroll
            for (int j = 0; j < 4; ++j) v[q][j] = *(const float4*)(xr + j * 256 + lane * 4); } }
#pragma unroll
        for (int q = 0; q < 4; ++q) { const int row = row0 + q * gridDim.x * 8; if (row < TT) { bf16_t* xb = (bf16_t*)(ws + OFF_XB) + (size_t)row * 1024; float s = 0.f;
#pragma unroll
            for (int j = 0; j < 4; ++j) { const float4 w = v[q][j]; s += w.x * w.x + w.y * w.y + w.z * w.z + w.w * w.w;
                u32x2 pk; pk[0] = pk_bf16(w.x, w.y); pk[1] = pk_bf16(w.z, w.w); *(u32x2*)(xb + j * 256 + lane * 4) = pk; }
#pragma unroll
            for (int o = 1; o < 64; o <<= 1) s += __shfl_xor(s, o);
            if (lane == 0) ((float*)(ws + OFF_SS))[row] = s; } }
    }
    for (int i = gtid; i < 4 * TT; i += gsz) ((float*)(ws + OFF_SS))[TT + i] = 0.f;
    for (int i = gtid; i < 2 * 2 * 8 * 4096; i += gsz) { const int e = i & 4095, hh = (i >> 12) & 7, which = (i >> 15) & 1, l = i >> 16, j = e >> 6, ii = e & 63;
        const float* w = which ? P.in[12] : P.in[10]; ((bf16_t*)(ws + OFF_WAX))[i] = f2bf(w[((size_t)(l * 8 + hh) * 64 + ii) * 64 + j]); }
    for (int i = (int)((blockIdx.x + gridDim.x - (gridDim.x >= 256 ? 16 : 0)) % gridDim.x) * 512 + tid; i < 4096 * 16; i += gsz) { const int h = i & 15, lgp = i >> 4, l = lgp >> 11, gp = lgp & 2047, g = gp >> 6, p = gp & 63;
        const float lr = P.in[15][lgp], li = P.in[16][lgp], dt = expf(P.in[22][l * 32 + g]);
        const float mag = expf(lr * dt), lbr = mag * cosf(li * dt), lbi = mag * sinf(li * dt);
        const float nr = lbr - 1.f, ni = lbi, den = lr * lr + li * li, gr = (nr * lr + ni * li) / den, gi = (ni * lr - nr * li) / den;
        const float br = P.in[17][(size_t)lgp * 16 + h], bi = P.in[18][(size_t)lgp * 16 + h];
        bf16_t* bb = (bf16_t*)(ws + OFF_BB) + ((size_t)(l * 32 + g) * 128) * 16;
        bb[(size_t)p * 16 + h] = f2bf(gr * br - gi * bi); bb[(size_t)(64 + p) * 16 + h] = f2bf(gr * bi + gi * br);
        bf16_t* cm = (bf16_t*)(ws + OFF_CM) + ((size_t)(l * 32 + g) * 16) * 128;
        cm[h * 128 + 2 * p] = f2bf(P.in[19][((size_t)(l * 32 + g) * 16 + h) * 64 + p]); cm[h * 128 + 2 * p + 1] = f2bf(-P.in[20][((size_t)(l * 32 + g) * 16 + h) * 64 + p]);
        if (h == 0) { float pr = lbr, pi = lbi;
            for (int sq = 0; sq < 5; ++sq) { const float t = pr * pr - pi * pi; pi = 2.f * pr * pi; pr = t; }
            float* lb = (float*)(ws + OFF_LB) + (size_t)l * 4 * 2048; lb[gp] = lbr; lb[2048 + gp] = lbi; lb[4096 + gp] = pr; lb[6144 + gp] = pi; } }
    { const int coff = (int)gridDim.x >= 256 ? 144 : 0;
      if ((int)blockIdx.x >= coff) convert_range(P, 448, 0, 384, 2368, (int)blockIdx.x - coff, (int)gridDim.x - coff, lds); }
}

__device__ __forceinline__ void norm_store(const bf16_t* gtile, bf16_t* dst) {
    const int tid = opaque_tid(), tok = tid >> 4, part = tid & 15; const bf16_t* src = gtile + tok * 520 + part * 32;
    float v[32]; float s = 0.f;
#pragma unroll
    for (int q = 0; q < 4; ++q) { const u32x4 w = *(const u32x4*)(src + q * 8);
#pragma unroll
        for (int e = 0; e < 4; ++e) { const float a = __uint_as_float(w[e] << 16), b = __uint_as_float(w[e] & 0xFFFF0000u); v[q * 8 + e * 2] = a; v[q * 8 + e * 2 + 1] = b; s += a * a + b * b; } }
    s += __shfl_xor(s, 1); s += __shfl_xor(s, 2); s += __shfl_xor(s, 4); s += __shfl_xor(s, 8);
    const float rs = rsqrtf(s * (1.f / 512.f) + EPS);
    bf16_t* d = dst + (size_t)tok * 1024 + part * 32;
#pragma unroll
    for (int q = 0; q < 4; ++q) { u32x4 pk;
#pragma unroll
        for (int e = 0; e < 4; ++e) pk[e] = pk_bf16(v[q * 8 + e * 2] * rs, v[q * 8 + e * 2 + 1] * rs);
        *(u32x4*)(d + q * 8) = pk; }
}

struct S5G { bf16x4 bbf[8]; bf16x8 cmf[4]; bf16x4 uf[2]; bf16x4 df; float lbr, lbi, xr, xi; };
template <bool FINAL>
__device__ __forceinline__ void s5_load(S5G& G, const Params& P, int l, int g, int row0, bool samp, int sb, int tile, int lane) {
    unsigned char* ws = P.ws; const int fr = lane & 15, fq = lane >> 4, p = lane;
    const float* lb = (const float*)(ws + OFF_LB) + (size_t)l * 4 * 2048;
    G.lbr = lb[g * 64 + p]; G.lbi = lb[2048 + g * 64 + p]; G.xr = 0.f; G.xi = 0.f; G.df = (bf16x4){0, 0, 0, 0};
    if (FINAL) { if (samp) { G.xr = P.in[4][((size_t)(l * 8 + sb) * 32 + g) * 64 + p]; G.xi = P.in[5][((size_t)(l * 8 + sb) * 32 + g) * 64 + p]; }
                 else { const float* cc = (const float*)(ws + OFF_S5C) + (size_t)tile * 4096; G.xr = cc[g * 64 + p]; G.xi = cc[2048 + g * 64 + p]; } }
    const bf16_t* bb = (const bf16_t*)(ws + OFF_BB) + ((size_t)(l * 32 + g) * 128) * 16;
#pragma unroll
    for (int nt = 0; nt < 8; ++nt) G.bbf[nt] = *(const bf16x4*)(bb + (size_t)(nt * 16 + fr) * 16 + fq * 4);
    const bf16_t* Z = (const bf16_t*)(ws + OFF_Z);
    if (FINAL) { const bf16_t* cm = (const bf16_t*)(ws + OFF_CM) + ((size_t)(l * 32 + g) * 16 + fr) * 128;
#pragma unroll
        for (int kk = 0; kk < 4; ++kk) G.cmf[kk] = *(const bf16x8*)(cm + kk * 32 + fq * 8);
        { const short dv = (short)f2bf(P.in[21][l * 512 + g * 16 + fr]); G.df[0] = (fq * 4 + 0 == fr) ? dv : (short)0; G.df[1] = (fq * 4 + 1 == fr) ? dv : (short)0; G.df[2] = (fq * 4 + 2 == fr) ? dv : (short)0; G.df[3] = (fq * 4 + 3 == fr) ? dv : (short)0; } }
#pragma unroll
    for (int sub = 0; sub < 2; ++sub) { const bf16_t* zu = Z + (size_t)(row0 + sub * 16) * INW + 1024 + g * 16;
        G.uf[sub] = *(const bf16x4*)(zu + (size_t)fr * INW + fq * 4);
    }
}

__device__ __forceinline__ void lru_final_fast(const Params& P, int l, int tile, int tid) {
    unsigned char* ws = P.ws; const int tok = tid >> 4, part = tid & 15, row = tile * 32 + tok;
    const unsigned* hl = (const unsigned*)(ws + OFF_HL) + (size_t)(row >> 1) * 512 + part * 32; const unsigned* pl = (const unsigned*)(ws + OFF_PL) + (size_t)(row >> 1) * 512 + part * 32;
    const bf16_t* gz = (const bf16_t*)(ws + OFF_Z) + (size_t)row * INW + 512 + part * 32; const float* cc = (const float*)(ws + OFF_LRUC) + (size_t)tile * 512 + part * 32;
    u32x4 hv[8], pv[8], gv[4]; f32x4 cv[8];
#pragma unroll
    for (int q = 0; q < 8; ++q) { hv[q] = *(const u32x4*)(hl + q * 4); pv[q] = *(const u32x4*)(pl + q * 4); cv[q] = *(const f32x4*)(cc + q * 4); }
#pragma unroll
    for (int q = 0; q < 4; ++q) gv[q] = *(const u32x4*)(gz + q * 8);
    const bool odd = row & 1;
    float v[32]; float sq = 0.f;
#pragma unroll
    for (int ci = 0; ci < 32; ++ci) {
        const unsigned hw = hv[ci >> 2][ci & 3], pw = pv[ci >> 2][ci & 3], gw = gv[ci >> 3][(ci >> 1) & 3];
        const float h0 = odd ? __uint_as_float(hw & 0xFFFF0000u) : __uint_as_float(hw << 16), p0 = odd ? __uint_as_float(pw & 0xFFFF0000u) : __uint_as_float(pw << 16),
                    g0 = (ci & 1) ? __uint_as_float(gw & 0xFFFF0000u) : __uint_as_float(gw << 16);
        const float y = (h0 + p0 * cv[ci >> 2][ci & 3]) * gelu_t(g0); v[ci] = y; sq += y * y; }
    sq += __shfl_xor(sq, 1); sq += __shfl_xor(sq, 2); sq += __shfl_xor(sq, 4); sq += __shfl_xor(sq, 8);
    const float rs = rsqrtf(sq * (1.f / 512.f) + EPS);
    bf16_t* d = (bf16_t*)(ws + OFF_MIX) + (size_t)row * 1024 + part * 32;
#pragma unroll
    for (int q = 0; q < 4; ++q) { u32x4 pk;
#pragma unroll
        for (int e = 0; e < 4; ++e) pk[e] = pk_bf16(v[q * 8 + e * 2] * rs, v[q * 8 + e * 2 + 1] * rs);
        *(u32x4*)(d + q * 8) = pk; }
    if (tile == NPT - 1) {
        const int c = tid; const bf16_t* zp = (const bf16_t*)(ws + OFF_Z) + (size_t)(TP - 3) * INW + c; float* oc = P.out + O_CONV_P + (size_t)l * 3 * 512;
        oc[c] = bf2f(zp[0]); oc[512 + c] = bf2f(zp[INW]); oc[1024 + c] = bf2f(zp[2 * INW]);
        P.out[O_LRU_P + (size_t)l * 512 + c] = ((const float*)(ws + OFF_LRUB))[(size_t)tile * 512 + c] + ((const float*)(ws + OFF_LRUA))[(size_t)tile * 512 + c] * ((const float*)(ws + OFF_LRUC))[(size_t)tile * 512 + c];
    }
}

template <bool FINAL, bool FAST = false>
__device__ __forceinline__ void mixer_tile(const Params& P, int l, int tile, unsigned char* lds, const int flags = 3) {
    const int tid = opaque_tid(), wid = tid >> 6, lane = tid & 63, fr = lane & 15, fq = lane >> 4;
    unsigned char* ws = P.ws;
    const bool samp = tile >= NPT; const int sb = tile - NPT;
    const int row0 = samp ? TP + sb * 32 : tile * 32;
    const bool seq_start = samp || tile == 0, seq_end = samp || tile == NPT - 1;
    bf16_t* gtile = (bf16_t*)lds;
    unsigned char* wsc = lds + LDS_GT + wid * LDS_WSC;
    float* regA = (float*)wsc; bf16_t* regB = (bf16_t*)(wsc + LDS_RA);
    const bf16_t* Z = (const bf16_t*)(ws + OFF_Z);
    bf16_t* MIX = (bf16_t*)(ws + OFF_MIX);
    __syncthreads();
    S5G cur;
    if (FAST) { lru_final_fast(P, l, tile, tid); s5_load<FINAL>(cur, P, l, wid * 4, row0, samp, sb, tile, lane); }
    else if (flags & 1) {
        const int c = wid * 64 + lane;
        const bf16_t* zc = Z + (size_t)row0 * INW + c;
        unsigned xraw[16];
#pragma unroll
        for (int t = 0; t < 16; ++t) xraw[t] = (unsigned)zc[(size_t)(2 * t) * INW] | ((unsigned)zc[(size_t)(2 * t + 1) * INW] << 16);
        float x3, x2, x1;
        if (seq_start) { if (samp) { const float* sc = P.in[2] + ((size_t)(l * 8 + sb) * 3) * 512; x3 = sc[c]; x2 = sc[512 + c]; x1 = sc[1024 + c]; } else { x3 = 0.f; x2 = 0.f; x1 = 0.f; } }
        else { const bf16_t* zp = Z + (size_t)(row0 - 3) * INW + c; x3 = bf2f(zp[0]); x2 = bf2f(zp[INW]); x1 = bf2f(zp[2 * INW]); }
        if (FINAL) {
#pragma unroll
            for (int t = 0; t < 32; ++t) gtile[t * 520 + c] = zc[(size_t)t * INW + 512];
        }
        const float* cw = P.in[8] + (size_t)l * 4 * 512; const float cw0 = cw[c], cw1 = cw[512 + c], cw2 = cw[1024 + c], cw3 = cw[1536 + c];
        const float cb = P.in[9][l * 512 + c], ba = P.in[11][l * 512 + c], bx = P.in[13][l * 512 + c];
        const float sp8 = -8.f * log1pf(__expf(-P.in[14][l * 512 + c]));
        float h = 0.f, Pa = 1.f;
        if (FINAL) h = samp ? P.in[3][(size_t)(l * 8 + sb) * 512 + c] : ((const float*)(ws + OFF_LRUC))[(size_t)tile * 512 + c];
        const bf16_t* wa = (const bf16_t*)(ws + OFF_WAX) + ((size_t)(l * 2 + 0) * 8 + wid) * 4096;
        const bf16_t* wx = (const bf16_t*)(ws + OFF_WAX) + ((size_t)(l * 2 + 1) * 8 + wid) * 4096;
        bf16x8 waf[4][2], wxf[4][2];
#pragma unroll
        for (int jt = 0; jt < 4; ++jt)
#pragma unroll
            for (int kk = 0; kk < 2; ++kk) { waf[jt][kk] = *(const bf16x8*)(wa + (jt * 16 + fr) * 64 + kk * 32 + fq * 8); wxf[jt][kk] = *(const bf16x8*)(wx + (jt * 16 + fr) * 64 + kk * 32 + fq * 8); }
        s5_load<FINAL>(cur, P, l, wid * 4, row0, samp, sb, tile, lane);
        bf16_t* xcs = regB; float* pre = regA;
#pragma unroll
        for (int sub = 0; sub < 2; ++sub) {
#pragma unroll
            for (int tt = 0; tt < 16; ++tt) { const float x0 = (tt & 1) ? __uint_as_float(xraw[sub * 8 + (tt >> 1)] & 0xFFFF0000u) : __uint_as_float(xraw[sub * 8 + (tt >> 1)] << 16); const float xc = cb + cw0 * x3 + cw1 * x2 + cw2 * x1 + cw3 * x0; x3 = x2; x2 = x1; x1 = x0; xcs[tt * 72 + lane] = f2bf(xc); }
            WAVE_SYNC();
            f32x4 aa[4], ax[4];
#pragma unroll
            for (int jt = 0; jt < 4; ++jt) { aa[jt] = (f32x4){0.f, 0.f, 0.f, 0.f}; ax[jt] = (f32x4){0.f, 0.f, 0.f, 0.f}; }
#pragma unroll
            for (int kk = 0; kk < 2; ++kk) { const bf16x8 bfv = *(const bf16x8*)(xcs + fr * 72 + kk * 32 + fq * 8);
#pragma unroll
                for (int jt = 0; jt < 4; ++jt) { aa[jt] = __builtin_amdgcn_mfma_f32_16x16x32_bf16(bfv, waf[jt][kk], aa[jt], 0, 0, 0); ax[jt] = __builtin_amdgcn_mfma_f32_16x16x32_bf16(bfv, wxf[jt][kk], ax[jt], 0, 0, 0); } }
#pragma unroll
            for (int jt = 0; jt < 4; ++jt) { *(f32x4*)(pre + (jt * 16 + fr) * 20 + fq * 4) = aa[jt]; *(f32x4*)(pre + 1280 + (jt * 16 + fr) * 20 + fq * 4) = ax[jt]; }
            WAVE_SYNC();
#pragma unroll 2
            for (int q = 0; q < 4; ++q) {
                typedef float f32x2 __attribute__((ext_vector_type(2)));
                const f32x4 pa4 = *(const f32x4*)(pre + lane * 20 + q * 4), px4 = *(const f32x4*)(pre + 1280 + lane * 20 + q * 4);
                const float NL2E = -1.4426950408889634f, sp8l = sp8 * 1.4426950408889634f;
#pragma unroll
                for (int ep = 0; ep < 2; ++ep) { const int tt = q * 4 + 2 * ep;
                    const f32x2 ua = ((f32x2){pa4[2 * ep], pa4[2 * ep + 1]} + (f32x2){ba, ba}) * NL2E, ux = ((f32x2){px4[2 * ep], px4[2 * ep + 1]} + (f32x2){bx, bx}) * NL2E;
                    const f32x2 da = (f32x2){__builtin_amdgcn_exp2f(ua[0]), __builtin_amdgcn_exp2f(ua[1])} + 1.f, dx = (f32x2){__builtin_amdgcn_exp2f(ux[0]), __builtin_amdgcn_exp2f(ux[1])} + 1.f;
                    const f32x2 rg = (f32x2){__builtin_amdgcn_rcpf(da[0]), __builtin_amdgcn_rcpf(da[1])}, ig = (f32x2){__builtin_amdgcn_rcpf(dx[0]), __builtin_amdgcn_rcpf(dx[1])};
                    const f32x2 la = rg * sp8l, av = (f32x2){__builtin_amdgcn_exp2f(la[0]), __builtin_amdgcn_exp2f(la[1])};
                    const f32x2 om = 1.f - av * av;
                    const f32x2 xc = (f32x2){bf2f(xcs[tt * 72 + lane]), bf2f(xcs[(tt + 1) * 72 + lane])};
                    const f32x2 bv = (f32x2){__builtin_amdgcn_sqrtf(fmaxf(om[0], 0.f)), __builtin_amdgcn_sqrtf(fmaxf(om[1], 0.f))} * (ig * xc);
                    const float h0 = av[0] * h + bv[0], p0 = Pa * av[0]; h = av[1] * h0 + bv[1]; Pa = p0 * av[1];
                    if (!FINAL) { ((unsigned*)(ws + OFF_HL))[(size_t)((row0 + sub * 16 + tt) >> 1) * 512 + c] = pk_bf16(h0, h); ((unsigned*)(ws + OFF_PL))[(size_t)((row0 + sub * 16 + tt) >> 1) * 512 + c] = pk_bf16(p0, Pa); }
                    if (FINAL) { bf16_t* gp = gtile + (sub * 16 + tt) * 520 + c; const float gl0 = bf2f(gp[0]), gl1 = bf2f(gp[520]); gp[0] = f2bf(h0 * gelu_t(gl0)); gp[520] = f2bf(h * gelu_t(gl1)); } }
            }
            WAVE_SYNC();
        }
        if (!FINAL) { ((float*)(ws + OFF_LRUA))[(size_t)tile * 512 + c] = Pa; ((float*)(ws + OFF_LRUB))[(size_t)tile * 512 + c] = h; }
        else if (seq_end) {
            float* oc = P.out + (samp ? O_CONV_S + ((size_t)(l * 8 + sb) * 3) * 512 : O_CONV_P + (size_t)l * 3 * 512);
            oc[c] = x3; oc[512 + c] = x2; oc[1024 + c] = x1;
            P.out[(samp ? O_LRU_S + (size_t)(l * 8 + sb) * 512 : O_LRU_P + (size_t)l * 512) + c] = h;
        }
    if (FINAL) { __syncthreads(); norm_store(gtile, MIX + (size_t)row0 * 1024); __syncthreads(); }
    }
    else s5_load<FINAL>(cur, P, l, wid * 4, row0, samp, sb, tile, lane);
    if (flags & 2) {
#pragma unroll
    for (int gi = 0; gi < 4; ++gi) {
        const int g = wid * 4 + gi, p = lane;
        S5G nxt;
        if (gi < 3) s5_load<FINAL>(nxt, P, l, g + 1, row0, samp, sb, tile, lane);
        float xr = cur.xr, xi = cur.xi; const float lbr = cur.lbr, lbi = cur.lbi;
        float* Bu = regA; bf16_t* xs = regB;
#pragma unroll
        for (int sub = 0; sub < 2; ++sub) {
#pragma unroll
            for (int ntp = 0; ntp < 4; ++ntp) {
                const f32x4 dr = __builtin_amdgcn_mfma_f32_16x16x16bf16_1k(cur.uf[sub], cur.bbf[ntp], (f32x4){0.f, 0.f, 0.f, 0.f}, 0, 0, 0);
                const f32x4 di = __builtin_amdgcn_mfma_f32_16x16x16bf16_1k(cur.uf[sub], cur.bbf[ntp + 4], (f32x4){0.f, 0.f, 0.f, 0.f}, 0, 0, 0);
                float* bp = Bu + (ntp * 16 + fr) * 36 + fq * 8;
                *(f32x4*)bp = (f32x4){dr[0], di[0], dr[1], di[1]}; *(f32x4*)(bp + 4) = (f32x4){dr[2], di[2], dr[3], di[3]}; }
            WAVE_SYNC();
            {
                typedef float f32x2 __attribute__((ext_vector_type(2)));
                f32x2 X = (f32x2){xr, xi}; const f32x2 LA = (f32x2){lbr, lbr}, LB = (f32x2){-lbi, lbi};
#pragma unroll
                for (int q = 0; q < 8; ++q) { const f32x4 b4 = *(const f32x4*)(Bu + p * 36 + q * 4);
#pragma unroll
                    for (int e = 0; e < 2; ++e) { const f32x2 bin = (f32x2){b4[2 * e], b4[2 * e + 1]};
                        X = LA * X + (LB * __builtin_shufflevector(X, X, 1, 0) + bin);
                        if (FINAL) ((unsigned*)xs)[(q * 2 + e) * 68 + p] = pk_bf16(X[0], X[1]); } }
                xr = X[0]; xi = X[1];
            }
            if (FINAL) {
                WAVE_SYNC();
                const f32x4 yd = __builtin_amdgcn_mfma_f32_16x16x16bf16_1k(cur.uf[sub], cur.df, (f32x4){0.f, 0.f, 0.f, 0.f}, 0, 0, 0);
                f32x4 y = (f32x4){0.f, 0.f, 0.f, 0.f};
#pragma unroll
                for (int kk = 0; kk < 4; ++kk) { const bf16x8 af = *(const bf16x8*)(xs + fr * 136 + kk * 32 + fq * 8); y = __builtin_amdgcn_mfma_f32_16x16x32_bf16(af, cur.cmf[kk], y, 0, 0, 0); }
#pragma unroll
                for (int r = 0; r < 4; ++r) { const int tok = fq * 4 + r; gtile[(sub * 16 + tok) * 520 + g * 16 + fr] = f2bf(gelu_t(y[r] + yd[r])); }
            }
            WAVE_SYNC();
        }
        if (!FINAL) { float* e = (float*)(ws + OFF_S5E) + (size_t)tile * 4096; e[g * 64 + p] = xr; e[2048 + g * 64 + p] = xi; }
        else if (seq_end) { const size_t o = samp ? ((size_t)(l * 8 + sb) * 32 + g) * 64 + p : ((size_t)l * 32 + g) * 64 + p;
            P.out[(samp ? O_RE_S : O_RE_P) + o] = xr; P.out[(samp ? O_IM_S : O_IM_P) + o] = xi; }
        if (gi < 3) cur = nxt;
    }
    if (FINAL) {
        const bf16_t* wg = (const bf16_t*)(ws + OFF_WGLU + l * SZ_WGLU) + (size_t)(wid * 64 + fr) * 512 + fq * 8;
        bf16x8 bq[2][4][4];
#pragma unroll
        for (int cb = 0; cb < 2; ++cb)
#pragma unroll
            for (int k4 = 0; k4 < 4; ++k4)
#pragma unroll
                for (int nt = 0; nt < 4; ++nt) bq[cb][k4][nt] = *(const bf16x8*)(wg + (size_t)nt * 16 * 512 + (cb * 4 + k4) * 32);
        float bg[4];
#pragma unroll
        for (int nt = 0; nt < 4; ++nt) bg[nt] = P.in[24][l * 512 + wid * 64 + nt * 16 + fr];
        __syncthreads();
        f32x4 acc[2][4];
#pragma unroll
        for (int mt = 0; mt < 2; ++mt)
#pragma unroll
            for (int nt = 0; nt < 4; ++nt) acc[mt][nt] = (f32x4){0.f, 0.f, 0.f, 0.f};
#pragma unroll
        for (int ch = 0; ch < 4; ++ch) {
#pragma unroll
            for (int k4 = 0; k4 < 4; ++k4) { const int kk = ch * 4 + k4;
                bf16x8 af[2];
#pragma unroll
                for (int mt = 0; mt < 2; ++mt) af[mt] = *(const bf16x8*)(gtile + (mt * 16 + fr) * 520 + kk * 32 + fq * 8);
#pragma unroll
                for (int mt = 0; mt < 2; ++mt)
#pragma unroll
                    for (int nt = 0; nt < 4; ++nt) acc[mt][nt] = __builtin_amdgcn_mfma_f32_16x16x32_bf16(af[mt], bq[ch & 1][k4][nt], acc[mt][nt], 0, 0, 0); }
            if (ch < 2) {
#pragma unroll
                for (int k4 = 0; k4 < 4; ++k4)
#pragma unroll
                    for (int nt = 0; nt < 4; ++nt) bq[ch & 1][k4][nt] = *(const bf16x8*)(wg + (size_t)nt * 16 * 512 + ((ch + 2) * 4 + k4) * 32); }
        }
        float o[2][4][4];
#pragma unroll
        for (int mt = 0; mt < 2; ++mt)
#pragma unroll
            for (int nt = 0; nt < 4; ++nt) { const int n = wid * 64 + nt * 16 + fr;
#pragma unroll
                for (int r = 0; r < 4; ++r) o[mt][nt][r] = bf2f(gtile[(mt * 16 + fq * 4 + r) * 520 + n]) * sigm(acc[mt][nt][r] + bg[nt]); }
        __syncthreads();
#pragma unroll
        for (int mt = 0; mt < 2; ++mt)
#pragma unroll
            for (int nt = 0; nt < 4; ++nt)
#pragma unroll
                for (int r = 0; r < 4; ++r) gtile[(mt * 16 + fq * 4 + r) * 520 + wid * 64 + nt * 16 + fr] = f2bf(o[mt][nt][r]);
        __syncthreads();
        norm_store(gtile, MIX + (size_t)row0 * 1024 + 512);
    }
    }
}

__device__ __forceinline__ void carry_phase(const Params& P, int l, unsigned char* lds, const int nitems) {
    unsigned char* ws = P.ws; const int tid = opaque_tid(); const int seg = tid >> 4, ch = tid & 15;
    float* sl = (float*)lds;
    for (int it = blockIdx.x; it < nitems; it += gridDim.x) {
        if (it < 32) {
            const int c = it * 16 + ch; const float* A = (const float*)(ws + OFF_LRUA) + (size_t)(seg * 16) * 512 + c; const float* B = (const float*)(ws + OFF_LRUB) + (size_t)(seg * 16) * 512 + c;
            float a[16], b[16];
#pragma unroll
            for (int k = 0; k < 16; ++k) { a[k] = A[(size_t)k * 512]; b[k] = B[(size_t)k * 512]; }
            float pa = 1.f, pb = 0.f;
#pragma unroll
            for (int k = 0; k < 16; ++k) { pb = a[k] * pb + b[k]; pa *= a[k]; }
            __syncthreads();
            sl[seg * 16 + ch] = pa; sl[512 + seg * 16 + ch] = pb;
            __syncthreads();
            float cs = 0.f;
            for (int s2 = 0; s2 < seg; ++s2) cs = sl[s2 * 16 + ch] * cs + sl[512 + s2 * 16 + ch];
            float* C = (float*)(ws + OFF_LRUC) + (size_t)(seg * 16) * 512 + c;
#pragma unroll
            for (int k = 0; k < 16; ++k) { C[(size_t)k * 512] = cs; cs = a[k] * cs + b[k]; }
        } else if (it < 160) {
            const int idx = (it - 32) * 16 + ch; const float* lb = (const float*)(ws + OFF_LB) + (size_t)l * 4 * 2048; const float qr = lb[4096 + idx], qi = lb[6144 + idx];
            const float* E = (const float*)(ws + OFF_S5E) + (size_t)(seg * 16) * 4096 + idx;
            float er[16], ei[16];
#pragma unroll
            for (int k = 0; k < 16; ++k) { er[k] = E[(size_t)k * 4096]; ei[k] = E[(size_t)k * 4096 + 2048]; }
            float xr = 0.f, xi = 0.f;
#pragma unroll
            for (int k = 0; k < 16; ++k) { const float nr = qr * xr - qi * xi + er[k], ni = qr * xi + qi * xr + ei[k]; xr = nr; xi = ni; }
            float q16r = qr, q16i = qi;
#pragma unroll
            for (int s2 = 0; s2 < 4; ++s2) { const float t = q16r * q16r - q16i * q16i; q16i = 2.f * q16r * q16i; q16r = t; }
            __syncthreads();
            sl[seg * 16 + ch] = xr; sl[512 + seg * 16 + ch] = xi;
            __syncthreads();
            float cr = 0.f, ci = 0.f;
            for (int s2 = 0; s2 < seg; ++s2) { const float nr = q16r * cr - q16i * ci + sl[s2 * 16 + ch], ni = q16r * ci + q16i * cr + sl[512 + s2 * 16 + ch]; cr = nr; ci = ni; }
            float* C = (float*)(ws + OFF_S5C) + (size_t)(seg * 16) * 4096 + idx;
#pragma unroll
            for (int k = 0; k < 16; ++k) { C[(size_t)k * 4096] = cr; C[(size_t)k * 4096 + 2048] = ci; const float nr = qr * cr - qi * ci + er[k], ni = qr * ci + qi * cr + ei[k]; cr = nr; ci = ni; }
        } else mixer_tile<true>(P, l, NPT + ((it - 160) & 7), lds, it < 168 ? 1 : 2);
    }
}

__device__ __forceinline__ void final_norm(const Params& P) {
    const float* ss = (const float*)(P.ws + OFF_SS) + 4 * TT; const int tid = opaque_tid(); const bf16_t* XB = (const bf16_t*)(P.ws + OFF_XB);
    const int cg = (tid & 127) * 8;
    const float4 g0 = *(const float4*)(P.in[32] + cg), g1 = *(const float4*)(P.in[32] + cg + 4);
    for (int r0 = blockIdx.x * 4 + (tid >> 7); r0 < TP; r0 += gridDim.x * 4 * 4) {
        u32x4 w[4]; float rs[4];
#pragma unroll
        for (int j = 0; j < 4; ++j) { const int row = r0 + j * gridDim.x * 4; if (row < TP) { w[j] = *(const u32x4*)(XB + (size_t)row * 1024 + cg); rs[j] = ss[row]; } }
#pragma unroll
        for (int j = 0; j < 4; ++j) { const int row = r0 + j * gridDim.x * 4; if (row < TP) { const float q = rsqrtf(rs[j] * (1.f / 1024.f) + EPS); float4 a, b;
            a.x = __uint_as_float(w[j][0] << 16) * q * g0.x; a.y = __uint_as_float(w[j][0] & 0xFFFF0000u) * q * g0.y; a.z = __uint_as_float(w[j][1] << 16) * q * g0.z; a.w = __uint_as_float(w[j][1] & 0xFFFF0000u) * q * g0.w;
            b.x = __uint_as_float(w[j][2] << 16) * q * g1.x; b.y = __uint_as_float(w[j][2] & 0xFFFF0000u) * q * g1.y; b.z = __uint_as_float(w[j][3] << 16) * q * g1.z; b.w = __uint_as_float(w[j][3] & 0xFFFF0000u) * q * g1.w;
            *(float4*)(P.out + (size_t)row * 1024 + cg) = a; *(float4*)(P.out + (size_t)row * 1024 + cg + 4) = b; } }
    }
    const int wid = tid >> 6, lane = tid & 63;
    for (int r = blockIdx.x + wid * gridDim.x; r < 256; r += gridDim.x * 8) { const bf16_t* xb = XB + (size_t)(TP + r) * 1024; float* xr = P.out + (size_t)(TP + r) * 1024; float4 v[4]; float sq = 0.f;
#pragma unroll
        for (int j = 0; j < 4; ++j) { const u32x2 w = *(const u32x2*)(xb + j * 256 + lane * 4); v[j].x = __uint_as_float(w[0] << 16); v[j].y = __uint_as_float(w[0] & 0xFFFF0000u); v[j].z = __uint_as_float(w[1] << 16); v[j].w = __uint_as_float(w[1] & 0xFFFF0000u); }
        for (int s0 = 0; s0 < 11; s0 += 4) {
            float4 w[4][4];
#pragma unroll
            for (int b = 0; b < 4; ++b) if (s0 + b < 11) { const float* pr = (const float*)(P.ws + OFF_PART) + ((size_t)(s0 + b) * 256 + r) * 1024;
#pragma unroll
                for (int j = 0; j < 4; ++j) w[b][j] = *(const float4*)(pr + j * 256 + lane * 4); }
#pragma unroll
            for (int b = 0; b < 4; ++b) if (s0 + b < 11) {
#pragma unroll
                for (int j = 0; j < 4; ++j) { v[j].x += w[b][j].x; v[j].y += w[b][j].y; v[j].z += w[b][j].z; v[j].w += w[b][j].w; } } }
#pragma unroll
        for (int j = 0; j < 4; ++j) sq += v[j].x * v[j].x + v[j].y * v[j].y + v[j].z * v[j].z + v[j].w * v[j].w;
#pragma unroll
        for (int o = 1; o < 64; o <<= 1) sq += __shfl_xor(sq, o);
        const float rs = rsqrtf(sq * (1.f / 1024.f) + EPS);
#pragma unroll
        for (int j = 0; j < 4; ++j) { const float4 g = *(const float4*)(P.in[32] + j * 256 + lane * 4); v[j].x *= rs * g.x; v[j].y *= rs * g.y; v[j].z *= rs * g.z; v[j].w *= rs * g.w; *(float4*)(xr + j * 256 + lane * 4) = v[j]; } }
}

#define GSYNC() do { XcdBarrier xb_; xb_.bar = (unsigned*)(P.ws + OFF_BAR); xb_.x = (unsigned)__builtin_amdgcn_readfirstlane((int)xb_xcc_id()); xb_.st = (volatile LAS unsigned*)(shm + LDS_XB); xcd_barrier(xb_); } while (0)
__global__ void __launch_bounds__(512, 2) hymba_fwd(Params P) {
    extern __shared__ __attribute__((aligned(16))) unsigned char shm[];
    cg::grid_group grid = cg::this_grid();
    unsigned char* ws = P.ws;
    float* ss = (float*)(ws + OFF_SS);
    bf16_t* XB = (bf16_t*)(ws + OFF_XB);
    unsigned* ctrs = (unsigned*)(ws + OFF_BAR) + CTR_WORD0;
    if (threadIdx.x < 4) ((volatile unsigned*)(shm + LDS_XB))[threadIdx.x] = 0u;
    __syncthreads();
    if (threadIdx.x == 0) (void)xb_add(&((unsigned*)(ws + OFF_BAR))[XB_XCNT((unsigned)__builtin_amdgcn_readfirstlane((int)xb_xcc_id()))], 1u);
    if (P.out == nullptr) grid.sync();
    prep_phase(P, shm);
    GSYNC();
    for (int l = 0; l < 2; ++l) {
        if (l) sample_fix(P, 11, ss + (size_t)(2 * l) * TT, ctrs + 128);
        const int g1_first = (65 * 6) % (int)gridDim.x, g1_idle = (int)gridDim.x - g1_first; const bool early_sample = (65 * 6 > (int)gridDim.x) && g1_idle >= 32 && (int)gridDim.x >= 176;
        run_gemm_g1(shm, XB, (const bf16_t*)(ws + OFF_WIN + l * SZ_WIN), INW, DM, EpiZ{(bf16_t*)(ws + OFF_Z), ss + (size_t)(2 * l) * TT}, l ? ctrs + 128 : nullptr, early_sample ? ctrs + 192 + 64 * l : nullptr);
        if (early_sample) {
            const int rk = (int)blockIdx.x - g1_first;
            if (rk >= 0 && rk < 16) { wait_counter(ctrs + 192 + 64 * l, 6 * 8); mixer_tile<true>(P, l, NPT + (rk & 7), shm, rk < 8 ? 1 : 2); }
            else if (rk >= 16 && l == 0) convert_range(P, 1664, 384, 1664, 0, rk - 16, g1_idle - 16, shm);
        } else if (l == 0) convert_by_idle(P, 65 * 6, 1664, 384, 1664, 0, shm);
        GSYNC();
        for (int t = blockIdx.x; t < NPT; t += gridDim.x) mixer_tile<false>(P, l, t, shm);
        GSYNC();
        carry_phase(P, l, shm, early_sample ? 160 : 176);
        if (early_sample && (int)blockIdx.x >= 160 && (int)blockIdx.x < 176)
            run_gemm_sample_split(shm, (const bf16_t*)(ws + OFF_MIX), (const bf16_t*)(ws + OFF_WOUT + l * SZ_WOUT), DM, DM, 4, (int)blockIdx.x - 160, EpiRes{XB, ss + (size_t)(2 * l + 1) * TT, (float*)(ws + OFF_PART)});
        if (l == 0) convert_by_idle(P, 176, 704, 2048, 704, 0, shm);
        GSYNC();
        for (int t = blockIdx.x; t < NPT; t += gridDim.x) mixer_tile<true, true>(P, l, t, shm);
        GSYNC();
        if (early_sample) run_gemm(shm, (const bf16_t*)(ws + OFF_MIX), (const bf16_t*)(ws + OFF_WOUT + l * SZ_WOUT), TP, DM, DM, EpiRes{XB, ss + (size_t)(2 * l + 1) * TT, (float*)(ws + OFF_PART)}, nullptr);
        else run_gemm_split(shm, (const bf16_t*)(ws + OFF_MIX), (const bf16_t*)(ws + OFF_WOUT + l * SZ_WOUT), DM, DM, 4,
                 EpiRes{XB, ss + (size_t)(2 * l + 1) * TT, (float*)(ws + OFF_PART)});
        GSYNC();
        sample_fix(P, 4, ss + (size_t)(2 * l + 1) * TT, ctrs + 64 * l);
        run_gemm(shm, XB, (const bf16_t*)(ws + OFF_WGU + l * SZ_WGU), TT, NGU, DM, EpiFF{(bf16_t*)(ws + OFF_FF), ss + (size_t)(2 * l + 1) * TT}, ctrs + 64 * l);
        if (l == 0) convert_by_idle(P, 65 * 22, 2112, 2816, 2048, 704, shm);
        GSYNC();
        run_gemm_split(shm, (const bf16_t*)(ws + OFF_FF), (const bf16_t*)(ws + OFF_WDN + l * SZ_WDN), DM, DFF, 11,
                 EpiRes{XB, ss + (size_t)(2 * l + 2) * TT, (float*)(ws + OFF_PART)});
        if (l == 0) convert_by_idle(P, 256 + 44, 704, 2816 + 2048, 704, 0, shm);
        GSYNC();
    }
    final_norm(P);
}

extern "C" void kernel_launch(void* const* d_in, const int* in_sizes, int n_in, void* d_out, int out_size, void* d_ws, size_t ws_size, hipStream_t stream) {
    static int grid = 0;
    if (grid == 0) {
        if (n_in != 33 || ws_size < WS_END) { fprintf(stderr, "kernel_launch: expected 33 inputs and >= %zu bytes of workspace (got %d, %zu)\n", (size_t)WS_END, n_in, ws_size); grid = -1; return; }
        int dev = 0, cus = 0, per_cu = 0;
        hipGetDevice(&dev); hipDeviceGetAttribute(&cus, hipDeviceAttributeMultiprocessorCount, dev);
        if (hipFuncSetAttribute((const void*)hymba_fwd, hipFuncAttributeMaxDynamicSharedMemorySize, LDS_BYTES) != hipSuccess) { fprintf(stderr, "kernel_launch: hipFuncSetAttribute failed\n"); grid = -1; return; }
        if (hipOccupancyMaxActiveBlocksPerMultiprocessor(&per_cu, (const void*)hymba_fwd, 512, LDS_BYTES) != hipSuccess || per_cu < 1) { fprintf(stderr, "kernel_launch: occupancy query gave %d\n", per_cu); per_cu = 1; }
        (void)hipGetLastError();
        grid = cus * per_cu;
    }
    if (grid < 0) return;
    if (hipMemsetAsync((unsigned char*)d_ws + OFF_BAR, 0, 16384, stream) != hipSuccess) { fprintf(stderr, "kernel_launch: memset of the barrier words failed\n"); return; }
    Params p{};
    for (int i = 0; i < 33; ++i) p.in[i] = (const float*)d_in[i];
    p.out = (float*)d_out; p.ws = (unsigned char*)d_ws;
    void* args[] = {&p};
    hipError_t e = hipLaunchCooperativeKernel((const void*)hymba_fwd, dim3(grid), dim3(512), args, LDS_BYTES, stream);
    if (e != hipSuccess) fprintf(stderr, "cooperative launch failed: %s (grid %d)\n", hipGetErrorString(e), grid);
}
```

```cpp
#include <hip/hip_runtime.h>
#include <hip/hip_cooperative_groups.h>
#include <cstdio>
namespace cg = cooperative_groups;

namespace pg8 {
#define PG8_LAS __attribute__((address_space(3)))
typedef unsigned short bf16_t;
typedef short bf16x8 __attribute__((ext_vector_type(8)));
typedef float f32x4 __attribute__((ext_vector_type(4)));
typedef unsigned u32x4 __attribute__((ext_vector_type(4)));
constexpr int BM = 256, BK = 64, HALF = 128, HTB = HALF * BK * 2  , STAGE_BYTES = 8 * HTB, NXCD = 8, WGM = 8;

__host__ __device__ __forceinline__ int lds_byte(int r, int c) { const int st = (r >> 4) * 2 + (c >> 5), rr = r & 15, cc = c & 31, ob = rr * 64 + cc * 2; return st * 1024 + (ob ^ (((ob >> 9) & 1) << 5)); }
__host__ __device__ __forceinline__ void stage_rc(int b, int& R, int& C) { const int st = b / 1024, sb = b % 1024, swz = sb ^ (((sb >> 9) & 1) << 5); R = (st >> 1) * 16 + swz / 64; C = (st & 1) * 32 + (swz % 64) / 2; }
__host__ __device__ __forceinline__ int perm32(int rho) { const int n = rho >> 4, i = rho & 15; return 8 * (i >> 2) + 4 * n + (i & 3); }

struct Unit { int pm, pn, k0t, nt, part; };
struct Gemm { const bf16_t* A; const bf16_t* Bt; int M, N, K; };

struct StaticOrder {
    int nM, nN, nwg, G, c, ntfull;
    __host__ __device__ void init(int M, int N, int G_, int c_) { nM = M / BM; nN = N / BM; nwg = nM * nN; G = G_; c = c_; ntfull = 0; }
    __host__ __device__ bool next(int i, Unit& u) const {
        const long L = (long)i * G + c; if (L >= nwg) return false;
        int wgid = (int)L; { const int q = nwg / NXCD, r = nwg % NXCD, xcd = wgid % NXCD, off = wgid / NXCD; wgid = (xcd < r ? xcd * (q + 1) : r * (q + 1) + (xcd - r) * q) + off; }
        const int nig = WGM * nN, gid = wgid / nig, fm = gid * WGM, gsz = (nM - fm) < WGM ? (nM - fm) : WGM;
        u.pm = fm + ((wgid % nig) % gsz); u.pn = (wgid % nig) / gsz; u.k0t = 0; u.nt = ntfull; u.part = 0; return true;
    }
    __device__ __forceinline__ void a_ready(const Unit&) const {}
    __device__ __forceinline__ void done(const Unit&) const {}
};
__device__ __forceinline__ unsigned cvt_pk_bf16(float lo, float hi) { unsigned r; asm volatile("v_cvt_pk_bf16_f32 %0, %1, %2" : "=v"(r) : "v"(lo), "v"(hi)); return r; }
template <class Epi, class Sched, bool STAMP = false>
__device__ __forceinline__ void gemm_phase(PG8_LAS unsigned char* lds, const Gemm g, const Sched& S, const Epi& E, unsigned long long* stamps) {
    int tid_ = threadIdx.x; asm volatile("" : "+v"(tid_));
    const int tid = tid_, wid = __builtin_amdgcn_readfirstlane(tid >> 6), lane = tid & 63, wr = wid >> 2, wc = wid & 3, fr = lane & 15, fq = lane >> 4;
    const int K = g.K;
    int ts_lo = 0, ts_hi = 0, nts = 0; const unsigned long long rt_entry = STAMP ? (unsigned long long)wall_clock64() : 0ull;
#define PG8_STAMP() do { if (STAMP && wid == 0 && nts < 64) { const unsigned long long _c = (unsigned long long)clock64(); \
        ts_lo = (lane == nts) ? (int)(unsigned)_c : ts_lo; ts_hi = (lane == nts) ? (int)(unsigned)(_c >> 32) : ts_hi; ++nts; } } while (0)
    PG8_STAMP();
    unsigned voffA[2], voffB[2];
#pragma unroll
    for (int i = 0; i < 2; ++i) { int R, C; stage_rc(tid * 16 + i * 8192, R, C); const int Rb = Epi::PERM ? ((R & ~31) + perm32(R & 31)) : R;
        voffA[i] = (unsigned)(R * K + C) * 2u; voffB[i] = (unsigned)(Rb * K + C) * 2u; }
    const size_t kstep = (size_t)(BK * 2);
    const size_t hstep = (size_t)HALF * K * 2;
    const size_t tstep = 2 * hstep;
    const unsigned ldsw = (unsigned)wid * 1024u;
    const int aoff = lds_byte(wr * 64 + fr, fq * 8), boff = lds_byte(wc * 32 + fr, fq * 8);
#define PG8_SA(b, h) (((b) * 2 + (h)) * HTB)
#define PG8_SB(b, h) ((4 + (b) * 2 + (h)) * HTB)
#define PG8_STAGE(bufoff, gbase, voff) do { _Pragma("unroll") for (int _i = 0; _i < 2; ++_i) \
        __builtin_amdgcn_global_load_lds((const unsigned*)((const char*)(gbase) + (voff)[_i]), (PG8_LAS unsigned*)(lds + (bufoff) + ldsw + _i * 8192), 16, 0, 0); } while (0)
#define PG8_LDA(dst, b, h) do { _Pragma("unroll") for (int m = 0; m < 4; ++m) _Pragma("unroll") for (int k = 0; k < 2; ++k) dst[m][k] = *(const PG8_LAS bf16x8*)(lds + PG8_SA(b, h) + aoff + m * 2048 + k * 1024); } while (0)
#define PG8_LDB(dst, b, h) do { _Pragma("unroll") for (int n = 0; n < 2; ++n) _Pragma("unroll") for (int k = 0; k < 2; ++k) dst[n][k] = *(const PG8_LAS bf16x8*)(lds + PG8_SB(b, h) + boff + n * 2048 + k * 1024); } while (0)
#define PG8_MMA(ai, bj, At, Bt) do { __builtin_amdgcn_s_setprio(1); _Pragma("unroll") for (int m = 0; m < 4; ++m) _Pragma("unroll") for (int n = 0; n < 2; ++n) _Pragma("unroll") for (int k = 0; k < 2; ++k) \
        acc[ai][bj][m][n] = __builtin_amdgcn_mfma_f32_16x16x32_bf16(Bt[n][k], At[m][k], acc[ai][bj][m][n], 0, 0, 0); __builtin_amdgcn_s_setprio(0); } while (0)
#define PG8_WAIT_V(n) asm volatile("s_waitcnt vmcnt(" #n ")" ::: "memory")
#define PG8_WAIT_L(n) asm volatile("s_waitcnt lgkmcnt(" #n ")" ::: "memory")
#define PG8_BAR __builtin_amdgcn_s_barrier()
#define PG8_SCHED __builtin_amdgcn_sched_barrier(0)
    Unit cur, nxt; int ui = 0;
    if (!S.next(0, cur)) return;
    f32x4 acc[2][2][4][2];
#pragma unroll
    for (int a = 0; a < 2; ++a)
#pragma unroll
        for (int b = 0; b < 2; ++b)
#pragma unroll
            for (int m = 0; m < 4; ++m)
#pragma unroll
                for (int n = 0; n < 2; ++n) acc[a][b][m][n] = (f32x4){0.f, 0.f, 0.f, 0.f};
    bf16x8 At[4][2], B0[2][2], B1[2][2];
    const char* cA = (const char*)g.A + (size_t)cur.pm * tstep + (size_t)cur.k0t * kstep; const char* cB = (const char*)g.Bt + (size_t)cur.pn * tstep + (size_t)cur.k0t * kstep;
    S.a_ready(cur);
    PG8_STAGE(PG8_SB(0, 0), cB, voffB); PG8_STAGE(PG8_SA(0, 0), cA, voffA); PG8_STAGE(PG8_SB(0, 1), cB + hstep, voffB); PG8_STAGE(PG8_SA(0, 1), cA + hstep, voffA);
    if (wr == 1) PG8_BAR;
    PG8_WAIT_V(4); PG8_BAR;
    PG8_STAGE(PG8_SB(1, 0), cB + kstep, voffB); PG8_STAGE(PG8_SA(1, 0), cA + kstep, voffA); PG8_STAGE(PG8_SB(1, 1), cB + hstep + kstep, voffB);
    PG8_WAIT_V(6); PG8_BAR;
    PG8_STAMP();
    for (;;) {
        const bool has_next = S.next(ui + 1, nxt);
        const char* nA = has_next ? (const char*)g.A + (size_t)nxt.pm * tstep + (size_t)nxt.k0t * kstep : cA; const char* nB = has_next ? (const char*)g.Bt + (size_t)nxt.pn * tstep + (size_t)nxt.k0t * kstep : cB;
        const int nt = cur.nt;
        for (int t = 0; t < nt; t += 2) {
            const bool last = (t == nt - 2);
            const char* a1 = cA + (size_t)(t + 1) * kstep;
            const char* a2 = last ? nA : cA + (size_t)(t + 2) * kstep; const char* b2 = last ? nB : cB + (size_t)(t + 2) * kstep;
            const char* a3 = a2 + kstep; const char* b3 = b2 + kstep;
            if (last && has_next) S.a_ready(nxt);
            PG8_LDB(B0, 0, 0); PG8_SCHED; PG8_LDA(At, 0, 0); PG8_STAGE(PG8_SA(1, 1), a1 + hstep, voffA);
            PG8_WAIT_L(8); PG8_BAR; PG8_WAIT_L(0); PG8_MMA(0, 0, At, B0); PG8_BAR; PG8_SCHED;
            PG8_LDB(B1, 0, 1); PG8_STAGE(PG8_SB(0, 0), b2, voffB);
            PG8_BAR; PG8_WAIT_L(0); PG8_MMA(0, 1, At, B1); PG8_BAR;
            PG8_LDA(At, 0, 1); PG8_STAGE(PG8_SA(0, 0), a2, voffA);
            PG8_BAR; PG8_WAIT_L(0); PG8_MMA(1, 0, At, B0); PG8_BAR; PG8_SCHED;
            PG8_STAGE(PG8_SB(0, 1), b2 + hstep, voffB);
            PG8_WAIT_V(6); PG8_BAR; PG8_MMA(1, 1, At, B1); PG8_BAR;
            PG8_LDB(B0, 1, 0); PG8_SCHED; PG8_LDA(At, 1, 0); PG8_STAGE(PG8_SA(0, 1), a2 + hstep, voffA);
            PG8_WAIT_L(8); PG8_BAR; PG8_WAIT_L(0); PG8_MMA(0, 0, At, B0); PG8_BAR; PG8_SCHED;
            PG8_LDB(B1, 1, 1); PG8_STAGE(PG8_SB(1, 0), b3, voffB);
            PG8_BAR; PG8_WAIT_L(0); PG8_MMA(0, 1, At, B1); PG8_BAR;
            PG8_LDA(At, 1, 1); PG8_STAGE(PG8_SA(1, 0), a3, voffA);
            PG8_BAR; PG8_WAIT_L(0); PG8_MMA(1, 0, At, B0); PG8_BAR; PG8_SCHED;
            PG8_STAGE(PG8_SB(1, 1), b3 + hstep, voffB);
            PG8_WAIT_V(6); PG8_BAR; PG8_MMA(1, 1, At, B1); PG8_BAR;
        }
        PG8_STAMP();
        if constexpr (!Epi::AFTER_DRAIN) { E(acc, cur, wr, wc, fr, fq); S.done(cur); }
        PG8_STAMP();
        if (!has_next) break;
#pragma unroll
        for (int a = 0; a < 2; ++a)
#pragma unroll
            for (int b = 0; b < 2; ++b)
#pragma unroll
                for (int m = 0; m < 4; ++m)
#pragma unroll
                    for (int n = 0; n < 2; ++n) acc[a][b][m][n] = (f32x4){0.f, 0.f, 0.f, 0.f};
        cur = nxt; cA = nA; cB = nB; ++ui;
    }
    PG8_WAIT_V(0);
    if (wr == 0) PG8_BAR;
    PG8_BAR;
    if constexpr (Epi::AFTER_DRAIN) { E.fused(acc, cur, wr, wc, fr, fq, lds, wid, lane); S.done(cur); }
    PG8_STAMP();
    if (STAMP && wid == 0) { stamps[lane] = lane < nts ? (((unsigned long long)(unsigned)ts_hi << 32) | (unsigned)ts_lo) : 0ull;
        if (lane == 62) stamps[62] = rt_entry; if (lane == 63) stamps[63] = (unsigned long long)wall_clock64(); }
#undef PG8_STAMP
#undef PG8_SA
#undef PG8_SB
#undef PG8_STAGE
#undef PG8_LDA
#undef PG8_LDB
#undef PG8_MMA
#undef PG8_WAIT_V
#undef PG8_WAIT_L
#undef PG8_BAR
#undef PG8_SCHED
}
}
#define XB_TMO      128
#define XB_XCNT(j)  (256  + 64 * (j))
#define XB_XSUB(j)  (1280 + 64 * (j))
#define XB_XGEN(j)  (2304 + 64 * (j))
#define XB_TOP      3328
#define XB_TOPGEN   3392
#define XCD_BAR_WORDS 3456
#define XB_SPIN_CAP (1u << 18)
#define LAS __attribute__((address_space(3)))

__device__ __forceinline__ unsigned xb_ld(unsigned* p)              { return __hip_atomic_load(p, __ATOMIC_RELAXED, __HIP_MEMORY_SCOPE_AGENT); }
__device__ __forceinline__ unsigned xb_add(unsigned* p, unsigned v) { return __hip_atomic_fetch_add(p, v, __ATOMIC_RELAXED, __HIP_MEMORY_SCOPE_AGENT); }
__device__ __forceinline__ unsigned xb_xcc_id() { return (unsigned)__builtin_amdgcn_s_getreg((3 << 11) | 20) & 0xFu; }
#define XB_SPIN(cond, bar) do { unsigned _sp = 0; while (cond) { __builtin_amdgcn_s_sleep(1); \
    if ((++_sp & 255u) == 0u) { if (xb_ld(&(bar)[XB_TMO])) break; if (_sp > XB_SPIN_CAP) { atomicAdd(&(bar)[XB_TMO], 1u); break; } } } } while (0)

struct XcdBarrier {
    unsigned* bar; unsigned x;
    volatile LAS unsigned* st;
};

__device__ __forceinline__ XcdBarrier xcd_barrier_post(unsigned* bar, volatile LAS unsigned* st) {
    XcdBarrier b; b.bar = bar; b.x = xb_xcc_id(); b.st = st;
    if (threadIdx.x == 0) (void)xb_add(&bar[XB_XCNT(b.x)], 1u);
    return b;
}
__device__ __forceinline__ void xcd_barrier_complete(unsigned* bar, unsigned x, unsigned& nloc, unsigned& nx) {
    const unsigned G = gridDim.x * gridDim.y * gridDim.z;
    unsigned sum, cnt, mine, sp = 0u;
    for (;;) {
        sum = 0u; cnt = 0u; mine = 0u;
#pragma unroll
        for (unsigned j = 0; j < 16; ++j) { const unsigned c = xb_ld(&bar[XB_XCNT(j)]); sum += c; cnt += (c > 0u) ? 1u : 0u; mine = (j == x) ? c : mine; }
        if (sum == G) break;
        __builtin_amdgcn_s_sleep(1);
        if ((++sp & 255u) == 0u) { if (xb_ld(&bar[XB_TMO])) break; if (sp > XB_SPIN_CAP) { atomicAdd(&bar[XB_TMO], 1u); break; } }
    }
    nloc = mine > 0u ? mine : 1u; nx = cnt > 0u ? cnt : 1u;
}

__device__ __forceinline__ void xcd_barrier(const XcdBarrier& b) {
    asm volatile("s_waitcnt vmcnt(0)" ::: "memory");
    __syncthreads();
    if (threadIdx.x == 0) {
        unsigned* bar = b.bar;
        __builtin_amdgcn_s_waitcnt(0);
        unsigned nloc = b.st[0], nx = b.st[1];
        if (nloc == 0u) { xcd_barrier_complete(bar, b.x, nloc, nx); b.st[0] = nloc; b.st[1] = nx; }
        const unsigned old = xb_add(&bar[XB_XSUB(b.x)], 1u);
        const unsigned gen = old / nloc;
        if (old + 1u == (gen + 1u) * nloc) {
            __builtin_amdgcn_fence(__ATOMIC_RELEASE, "agent");
            asm volatile("s_waitcnt vmcnt(0)" ::: "memory");
            const unsigned og = xb_add(&bar[XB_TOP], 1u);
            const unsigned tg = og / nx;
            if (og + 1u == (tg + 1u) * nx) xb_add(&bar[XB_TOPGEN], 1u);
            else XB_SPIN(xb_ld(&bar[XB_TOPGEN]) == tg, bar);
            __builtin_amdgcn_fence(__ATOMIC_ACQUIRE, "agent");
            xb_add(&bar[XB_XGEN(b.x)], 1u);
            asm volatile("s_waitcnt vmcnt(0)" ::: "memory");
        } else {
            XB_SPIN(xb_ld(&bar[XB_XGEN(b.x)]) == gen, bar);
            __builtin_amdgcn_fence(__ATOMIC_ACQUIRE, "agent");
            asm volatile("s_waitcnt vmcnt(0)" ::: "memory");
        }
    }
    __syncthreads();
}


using pg8::bf16_t; using pg8::bf16x8; using pg8::f32x4; using pg8::Unit;
typedef short bf16x4 __attribute__((ext_vector_type(4)));
typedef unsigned u32x4 __attribute__((ext_vector_type(4)));
typedef unsigned u32x2 __attribute__((ext_vector_type(2)));

constexpr int TP = 16384, TT = 16640, DM = 1024, INW = 1536, DFF = 2816, NGU = 5632;
constexpr int NPT = 512;
constexpr float EPS = 1e-6f;

constexpr size_t SZ_WIN = (size_t)1536 * 1024 * 2, SZ_WOUT = (size_t)1024 * 1024 * 2, SZ_WGU = (size_t)5632 * 1024 * 2, SZ_WDN = (size_t)1024 * 2816 * 2,
                 SZ_WGLU = (size_t)512 * 512 * 2, SZ_WAX = (size_t)2 * 8 * 64 * 64 * 2;
constexpr size_t OFF_WIN = 0;
constexpr size_t OFF_WOUT = OFF_WIN + 2 * SZ_WIN;
constexpr size_t OFF_WGU = OFF_WOUT + 2 * SZ_WOUT;
constexpr size_t OFF_WDN = OFF_WGU + 2 * SZ_WGU;
constexpr size_t OFF_WGLU = OFF_WDN + 2 * SZ_WDN;
constexpr size_t OFF_WAX = OFF_WGLU + 2 * SZ_WGLU;
constexpr size_t OFF_BB = OFF_WAX + 2 * SZ_WAX;
constexpr size_t OFF_CM = OFF_BB + (size_t)2 * 32 * 128 * 16 * 2;
constexpr size_t OFF_LB = OFF_CM + (size_t)2 * 32 * 16 * 128 * 2;
constexpr size_t OFF_SS = OFF_LB + (size_t)2 * 4 * 2048 * 4;
constexpr size_t OFF_LRUA = OFF_SS + (size_t)5 * TT * 4;
constexpr size_t OFF_LRUB = OFF_LRUA + (size_t)NPT * 512 * 4;
constexpr size_t OFF_LRUC = OFF_LRUB + (size_t)NPT * 512 * 4;
constexpr size_t OFF_S5E = OFF_LRUC + (size_t)NPT * 512 * 4;
constexpr size_t OFF_S5C = OFF_S5E + (size_t)NPT * 2 * 2048 * 4;
constexpr size_t OFF_XB = OFF_S5C + (size_t)NPT * 2 * 2048 * 4;
constexpr size_t OFF_R = OFF_XB + (size_t)TT * 1024 * 2;
constexpr size_t OFF_Z = OFF_R, OFF_MIX = OFF_R + (size_t)TT * 1536 * 2, OFF_FF = OFF_R;
constexpr size_t OFF_BAR = OFF_R + (size_t)TT * 2816 * 2;
constexpr size_t OFF_PART = OFF_BAR + 16384;
constexpr size_t OFF_HL = OFF_PART + (size_t)11 * 256 * 1024 * 4;
constexpr size_t OFF_PL = OFF_HL + (size_t)TP * 512 * 2;
constexpr size_t WS_END = OFF_PL + (size_t)TP * 512 * 2;

constexpr size_t O_Y = 0, O_CONV_P = (size_t)TT * 1024, O_LRU_P = O_CONV_P + 3072, O_RE_P = O_LRU_P + 1024, O_IM_P = O_RE_P + 4096,
                 O_CONV_S = O_IM_P + 4096, O_LRU_S = O_CONV_S + 24576, O_RE_S = O_LRU_S + 8192, O_IM_S = O_RE_S + 32768;

constexpr int LDS_GT = 32 * 520 * 2;
constexpr int LDS_RA = 10240;
constexpr int LDS_WSC = LDS_RA + 4352;
constexpr int LDS_BYTES = 150528;
constexpr int LDS_XB = LDS_BYTES - 16;

struct Params { const float* in[33]; float* out; unsigned char* ws; };

__device__ __forceinline__ unsigned pk_bf16(float lo, float hi) { unsigned r; asm("v_cvt_pk_bf16_f32 %0, %1, %2" : "=v"(r) : "v"(lo), "v"(hi)); return r; }
__device__ __forceinline__ bf16_t f2bf(float f) { return (bf16_t)pk_bf16(f, f); }
__device__ __forceinline__ float bf2f(bf16_t b) { return __uint_as_float(((unsigned)b) << 16); }
__device__ __forceinline__ float sigm(float x) { return __builtin_amdgcn_rcpf(1.f + __expf(-x)); }
__device__ __forceinline__ float gelu_t(float x) { return x * sigm(1.5957691216057308f * (x + 0.044715f * x * x * x)); }
__device__ __forceinline__ int opaque_tid() { int t = threadIdx.x; asm volatile("" : "+v"(t)); return t; }
#define WAVE_SYNC() do { __builtin_amdgcn_fence(__ATOMIC_RELEASE, "wavefront"); __builtin_amdgcn_wave_barrier(); __builtin_amdgcn_fence(__ATOMIC_ACQUIRE, "wavefront"); } while (0)

struct EpiZ {
    static constexpr bool PERM = true, AFTER_DRAIN = false;
    bf16_t* O; const float* ss;
    __device__ __forceinline__ void operator()(const f32x4 (&acc)[2][2][4][2], const Unit& u, int wr, int wc, int fr, int fq) const {
        const int row0 = u.pm * 256 + wr * 64 + fr, col0 = u.pn * 256 + wc * 32 + 8 * fq;
        float rs[2][4];
#pragma unroll
        for (int ai = 0; ai < 2; ++ai)
#pragma unroll
            for (int m = 0; m < 4; ++m) rs[ai][m] = ss[row0 + ai * 128 + m * 16];
#pragma unroll
        for (int ai = 0; ai < 2; ++ai)
#pragma unroll
            for (int m = 0; m < 4; ++m) {
                const int row = row0 + ai * 128 + m * 16; const float r1 = rsqrtf(rs[ai][m] * (1.f / 1024.f) + EPS);
                bf16_t* rp = O + (size_t)row * INW + col0;
#pragma unroll
                for (int bj = 0; bj < 2; ++bj) { const f32x4 v0 = acc[ai][bj][m][0] * r1, v1 = acc[ai][bj][m][1] * r1;
                    u32x4 pk; pk[0] = pk_bf16(v0[0], v0[1]); pk[1] = pk_bf16(v0[2], v0[3]); pk[2] = pk_bf16(v1[0], v1[1]); pk[3] = pk_bf16(v1[2], v1[3]);
                    *(u32x4*)(rp + bj * 128) = pk; }
            }
    }
};
struct EpiFF {
    static constexpr bool PERM = true, AFTER_DRAIN = false;
    bf16_t* O; const float* ss;
    __device__ __forceinline__ void operator()(const f32x4 (&acc)[2][2][4][2], const Unit& u, int wr, int wc, int fr, int fq) const {
        const int row0 = u.pm * 256 + wr * 64 + fr, f0 = u.pn * 128 + wc * 32 + 8 * fq;
        float rs[2][4];
#pragma unroll
        for (int ai = 0; ai < 2; ++ai)
#pragma unroll
            for (int m = 0; m < 4; ++m) rs[ai][m] = ss[row0 + ai * 128 + m * 16];
#pragma unroll
        for (int ai = 0; ai < 2; ++ai)
#pragma unroll
            for (int m = 0; m < 4; ++m) {
                const int row = row0 + ai * 128 + m * 16; const float r1 = rsqrtf(rs[ai][m] * (1.f / 1024.f) + EPS), r2 = r1 * -1.4426950408889634f;
                float o[8];
#pragma unroll
                for (int n = 0; n < 2; ++n)
#pragma unroll
                    for (int i = 0; i < 4; ++i) { const float ag = acc[ai][0][m][n][i];
                        o[n * 4 + i] = (ag * r1) * (acc[ai][1][m][n][i] * r1) * __builtin_amdgcn_rcpf(1.f + __builtin_amdgcn_exp2f(ag * r2)); }
                u32x4 pk; pk[0] = pk_bf16(o[0], o[1]); pk[1] = pk_bf16(o[2], o[3]); pk[2] = pk_bf16(o[4], o[5]); pk[3] = pk_bf16(o[6], o[7]);
                *(u32x4*)(O + (size_t)row * DFF + f0) = pk;
            }
    }
};
struct EpiRes {
    static constexpr bool PERM = true, AFTER_DRAIN = false;
    bf16_t* xb; float* ss; float* part;
    __device__ __forceinline__ void operator()(const f32x4 (&acc)[2][2][4][2], const Unit& u, int wr, int wc, int fr, int fq) const {
        const int row0 = u.pm * 256 + wr * 64 + fr, col0 = u.pn * 256 + wc * 32 + 8 * fq;
        if (u.part) {
            float* pb = part + ((size_t)(u.k0t / u.nt) * 256 + (wr * 64 + fr)) * 1024 + col0;
#pragma unroll
            for (int ai = 0; ai < 2; ++ai)
#pragma unroll
                for (int m = 0; m < 4; ++m) { float* op = pb + (size_t)(ai * 128 + m * 16) * 1024;
#pragma unroll
                    for (int bj = 0; bj < 2; ++bj)
#pragma unroll
                        for (int n = 0; n < 2; ++n) *(f32x4*)(op + bj * 128 + 4 * n) = acc[ai][bj][m][n]; }
            return;
        }
#pragma unroll
        for (int ai = 0; ai < 2; ++ai) {
            u32x4 xv[4][2];
#pragma unroll
            for (int m = 0; m < 4; ++m)
#pragma unroll
                for (int bj = 0; bj < 2; ++bj) xv[m][bj] = *(const u32x4*)(xb + (size_t)(row0 + ai * 128 + m * 16) * 1024 + col0 + bj * 128);
#pragma unroll
            for (int m = 0; m < 4; ++m) {
                const int row = row0 + ai * 128 + m * 16; bf16_t* bp = xb + (size_t)row * 1024 + col0; float sq = 0.f;
#pragma unroll
                for (int bj = 0; bj < 2; ++bj) { const u32x4 w = xv[m][bj]; u32x4 pk;
#pragma unroll
                    for (int n = 0; n < 2; ++n) { const f32x4 a = acc[ai][bj][m][n];
                        const float v0 = __uint_as_float(w[2 * n] << 16) + a[0], v1 = __uint_as_float(w[2 * n] & 0xFFFF0000u) + a[1], v2 = __uint_as_float(w[2 * n + 1] << 16) + a[2], v3 = __uint_as_float(w[2 * n + 1] & 0xFFFF0000u) + a[3];
                        pk[2 * n] = pk_bf16(v0, v1); pk[2 * n + 1] = pk_bf16(v2, v3); sq += v0 * v0 + v1 * v1 + v2 * v2 + v3 * v3; }
                    *(u32x4*)(bp + bj * 128) = pk; }
                sq += __shfl_xor(sq, 16); sq += __shfl_xor(sq, 32);
                if (fq == 0) atomicAdd(ss + row, sq);
            }
        }
    }
};
struct SplitOrder : pg8::StaticOrder {
    int nwgP, nsplit, ntS, nNs;
    __device__ __forceinline__ void init2(int N, int K, int G_, int c_, int nsplit_) { init(TP, N, G_, c_); ntfull = K / 64; nwgP = nwg; nNs = N / 256; nsplit = nsplit_; ntS = ntfull / nsplit_; }
    __device__ __forceinline__ bool next(int i, Unit& u) const {
        const long L = (long)i * G + c;
        if (L < nwgP) return pg8::StaticOrder::next(i, u);
        const int sidx = (int)(L - nwgP); if (sidx >= nNs * nsplit) return false;
        u.pm = 64; u.pn = sidx % nNs; u.k0t = (sidx / nNs) * ntS; u.nt = ntS; u.part = 1; return true;
    }
};
__device__ __forceinline__ void sample_fix(const Params& P, int nsplit, float* ss_out, unsigned* ctr) {
    const int tid = opaque_tid(), wid = tid >> 6, lane = tid & 63; const float* part = (const float*)(P.ws + OFF_PART);
    for (int r = blockIdx.x * 8 + wid; r < 256; r += gridDim.x * 8) { const int row = TP + r; bf16_t* xb = (bf16_t*)(P.ws + OFF_XB) + (size_t)row * 1024; float sq = 0.f;
        float4 v[4];
#pragma unroll
        for (int j = 0; j < 4; ++j) { const u32x2 w = *(const u32x2*)(xb + j * 256 + lane * 4); v[j].x = __uint_as_float(w[0] << 16); v[j].y = __uint_as_float(w[0] & 0xFFFF0000u); v[j].z = __uint_as_float(w[1] << 16); v[j].w = __uint_as_float(w[1] & 0xFFFF0000u); }
        for (int s0 = 0; s0 < nsplit; s0 += 4) {
            float4 w[4][4];
#pragma unroll
            for (int b = 0; b < 4; ++b) if (s0 + b < nsplit) { const float* pr = part + ((size_t)(s0 + b) * 256 + r) * 1024;
#pragma unroll
                for (int j = 0; j < 4; ++j) w[b][j] = *(const float4*)(pr + j * 256 + lane * 4); }
#pragma unroll
            for (int b = 0; b < 4; ++b) if (s0 + b < nsplit) {
#pragma unroll
                for (int j = 0; j < 4; ++j) { v[j].x += w[b][j].x; v[j].y += w[b][j].y; v[j].z += w[b][j].z; v[j].w += w[b][j].w; } } }
#pragma unroll
        for (int j = 0; j < 4; ++j) { sq += v[j].x * v[j].x + v[j].y * v[j].y + v[j].z * v[j].z + v[j].w * v[j].w;
            u32x2 pk; pk[0] = pk_bf16(v[j].x, v[j].y); pk[1] = pk_bf16(v[j].z, v[j].w); *(u32x2*)(xb + j * 256 + lane * 4) = pk; }
#pragma unroll
        for (int o = 1; o < 64; o <<= 1) sq += __shfl_xor(sq, o);
        if (lane == 0) ss_out[row] = sq;
        __builtin_amdgcn_fence(__ATOMIC_RELEASE, "agent");
        asm volatile("s_waitcnt vmcnt(0)" ::: "memory");
        if (lane == 0) __hip_atomic_fetch_add(ctr, 1u, __ATOMIC_RELAXED, __HIP_MEMORY_SCOPE_AGENT); }
}
constexpr int CTR_WORD0 = 3584;
struct WaitOrder : pg8::StaticOrder {
    const unsigned* ready;
    __device__ __forceinline__ void a_ready(const Unit& u) const {
        if (ready == nullptr || u.pm != 64) return;
        if (threadIdx.x < 64) {
            unsigned polls = 0;
            while ((unsigned)__builtin_amdgcn_readfirstlane((int)__hip_atomic_load(ready, __ATOMIC_RELAXED, __HIP_MEMORY_SCOPE_AGENT)) < 256u) { if (++polls > (1u << 22)) break; __builtin_amdgcn_s_sleep(2); }
            __builtin_amdgcn_fence(__ATOMIC_ACQUIRE, "agent");
            asm volatile("s_waitcnt vmcnt(0)" ::: "memory");
        }
        asm volatile("" ::: "memory"); __builtin_amdgcn_s_barrier(); asm volatile("" ::: "memory");
    }
};
template <class Epi> __device__ __forceinline__ void run_gemm(unsigned char* lds, const bf16_t* A, const bf16_t* Bt, int M, int N, int K, const Epi& E, const unsigned* ready) {
    pg8::Gemm g{A, Bt, M, N, K}; WaitOrder S; S.init(M, N, (int)gridDim.x, (int)blockIdx.x); S.ntfull = K / 64; S.ready = ready;
    pg8::gemm_phase<Epi, WaitOrder, false>((PG8_LAS unsigned char*)lds, g, S, E, nullptr);
}
struct SampleFirstOrder : pg8::StaticOrder {
    const unsigned* ready; unsigned* donectr; int nNs;
    __device__ __forceinline__ void init3(int N, int K, int G_, int c_) { init(TP, N, G_, c_); ntfull = K / 64; nNs = N / 256; }
    __device__ __forceinline__ bool next(int i, Unit& u) const {
        long L = (long)i * G + c; u.k0t = 0; u.nt = ntfull; u.part = 0;
        if (L < nNs) { u.pm = 64; u.pn = (int)L; return true; }
        L -= nNs; if (L >= nwg) return false;
        int wgid = (int)L; { const int q = nwg / pg8::NXCD, r = nwg % pg8::NXCD, xcd = wgid % pg8::NXCD, off = wgid / pg8::NXCD; wgid = (xcd < r ? xcd * (q + 1) : r * (q + 1) + (xcd - r) * q) + off; }
        const int nig = pg8::WGM * nN, gid = wgid / nig, fm = gid * pg8::WGM, gsz = (nM - fm) < pg8::WGM ? (nM - fm) : pg8::WGM;
        u.pm = fm + ((wgid % nig) % gsz); u.pn = (wgid % nig) / gsz; return true;
    }
    __device__ __forceinline__ void a_ready(const Unit& u) const {
        if (ready == nullptr || u.pm != 64) return;
        if (threadIdx.x < 64) {
            unsigned polls = 0;
            while ((unsigned)__builtin_amdgcn_readfirstlane((int)__hip_atomic_load(ready, __ATOMIC_RELAXED, __HIP_MEMORY_SCOPE_AGENT)) < 256u) { if (++polls > (1u << 22)) break; __builtin_amdgcn_s_sleep(2); }
            __builtin_amdgcn_fence(__ATOMIC_ACQUIRE, "agent");
            asm volatile("s_waitcnt vmcnt(0)" ::: "memory");
        }
        asm volatile("" ::: "memory"); __builtin_amdgcn_s_barrier(); asm volatile("" ::: "memory");
    }
    __device__ __forceinline__ void done(const Unit& u) const {
        if (u.pm != 64 || donectr == nullptr) return;
        __builtin_amdgcn_fence(__ATOMIC_RELEASE, "agent"); asm volatile("s_waitcnt vmcnt(0)" ::: "memory");
        if ((threadIdx.x & 63) == 0) __hip_atomic_fetch_add(donectr, 1u, __ATOMIC_RELAXED, __HIP_MEMORY_SCOPE_AGENT);
    }
};
template <class Epi> __device__ __forceinline__ void run_gemm_g1(unsigned char* lds, const bf16_t* A, const bf16_t* Bt, int N, int K, const Epi& E, const unsigned* ready, unsigned* donectr) {
    pg8::Gemm g{A, Bt, TT, N, K}; SampleFirstOrder S; S.init3(N, K, (int)gridDim.x, (int)blockIdx.x); S.ready = ready; S.donectr = donectr;
    pg8::gemm_phase<Epi, SampleFirstOrder, false>((PG8_LAS unsigned char*)lds, g, S, E, nullptr);
}
template <class Epi> __device__ __forceinline__ void run_gemm_sample_split(unsigned char* lds, const bf16_t* A, const bf16_t* Bt, int N, int K, int nsplit, int rank, const Epi& E) {
    pg8::Gemm g{A, Bt, TT, N, K}; SplitOrder S; S.init2(N, K, 1 << 20, rank, nsplit); S.nwgP = 0;
    pg8::gemm_phase<Epi, SplitOrder, false>((PG8_LAS unsigned char*)lds, g, S, E, nullptr);
}
__device__ __forceinline__ void wait_counter(const unsigned* ctr, unsigned need) {
    if (threadIdx.x < 64) {
        unsigned polls = 0;
        while ((unsigned)__builtin_amdgcn_readfirstlane((int)__hip_atomic_load(ctr, __ATOMIC_RELAXED, __HIP_MEMORY_SCOPE_AGENT)) < need) { if (++polls > (1u << 22)) break; __builtin_amdgcn_s_sleep(2); }
        __builtin_amdgcn_fence(__ATOMIC_ACQUIRE, "agent");
        asm volatile("s_waitcnt vmcnt(0)" ::: "memory");
    }
    __syncthreads();
}
template <class Epi> __device__ __forceinline__ void run_gemm_split(unsigned char* lds, const bf16_t* A, const bf16_t* Bt, int N, int K, int nsplit, const Epi& E) {
    pg8::Gemm g{A, Bt, TT, N, K}; SplitOrder S; S.init2(N, K, (int)gridDim.x, (int)blockIdx.x, nsplit);
    pg8::gemm_phase<Epi, SplitOrder, false>((PG8_LAS unsigned char*)lds, g, S, E, nullptr);
}

struct TrTile { const float* src; const float* gain; bf16_t* dst; int N, K, k0, n0, drow; };
__device__ __forceinline__ TrTile tr_decode(const Params& P, int it) {
    unsigned char* ws = P.ws; TrTile t; const int l = it / 2816; int i = it % 2816; int kt, nt;
    if (i < 384) { kt = i / 24; nt = i % 24; t.src = P.in[7] + (size_t)l * 1024 * 1536; t.N = 1536; t.K = 1024; t.gain = P.in[6] + l * 1024 + kt * 64; t.dst = (bf16_t*)(ws + OFF_WIN + l * SZ_WIN); t.drow = nt * 64; }
    else if (i < 640) { i -= 384; kt = i / 16; nt = i % 16; t.src = P.in[27] + (size_t)l * 1024 * 1024; t.N = 1024; t.K = 1024;
        t.gain = kt < 8 ? P.in[25] + l * 512 + kt * 64 : P.in[26] + l * 512 + (kt - 8) * 64; t.dst = (bf16_t*)(ws + OFF_WOUT + l * SZ_WOUT); t.drow = nt * 64; }
    else if (i < 2048) { const bool up = i >= 1344; i -= up ? 1344 : 640; kt = i / 44; nt = i % 44; t.src = (up ? P.in[30] : P.in[29]) + (size_t)l * 1024 * 2816; t.N = 2816; t.K = 1024;
        t.gain = P.in[28] + l * 1024 + kt * 64; t.dst = (bf16_t*)(ws + OFF_WGU + l * SZ_WGU); const int f0 = nt * 64; t.drow = (f0 >> 7) * 256 + (f0 & 127) + (up ? 128 : 0); }
    else if (i < 2752) { i -= 2048; kt = i / 16; nt = i % 16; t.src = P.in[31] + (size_t)l * 2816 * 1024; t.N = 1024; t.K = 2816; t.gain = nullptr; t.dst = (bf16_t*)(ws + OFF_WDN + l * SZ_WDN); t.drow = nt * 64; }
    else { i -= 2752; kt = i / 8; nt = i % 8; t.src = P.in[23] + (size_t)l * 512 * 512; t.N = 512; t.K = 512; t.gain = nullptr; t.dst = (bf16_t*)(ws + OFF_WGLU + l * SZ_WGLU); t.drow = nt * 64; }
    t.k0 = kt * 64; t.n0 = nt * 64; return t;
}

__device__ __forceinline__ void convert_range(const Params& P, int count, int base, int split_at, int jump, int rank, int nblk, unsigned char* lds) {
    float* tile = (float*)lds; const int tid = opaque_tid();
    __syncthreads();
    for (int v0 = rank * 4; v0 < count; v0 += nblk * 4) {
        float4 v[4][2]; float gn[4][2];
#pragma unroll
        for (int j = 0; j < 4; ++j) if (v0 + j < count) { const int vv = v0 + j; const TrTile t = tr_decode(P, base + (vv < split_at ? vv : vv + jump));
#pragma unroll
            for (int i = 0; i < 2; ++i) { const int kk = (tid >> 4) + i * 32, nq = tid & 15; v[j][i] = *(const float4*)(t.src + (size_t)(t.k0 + kk) * t.N + t.n0 + nq * 4); gn[j][i] = t.gain ? t.gain[kk] : 1.f; } }
        __syncthreads();
#pragma unroll
        for (int j = 0; j < 4; ++j) if (v0 + j < count) {
#pragma unroll
            for (int i = 0; i < 2; ++i) { const int kk = (tid >> 4) + i * 32, nq = tid & 15; float* tp = tile + j * 4160 + kk * 65 + nq * 4; const float g = gn[j][i];
                tp[0] = v[j][i].x * g; tp[1] = v[j][i].y * g; tp[2] = v[j][i].z * g; tp[3] = v[j][i].w * g; } }
        __syncthreads();
#pragma unroll
        for (int j = 0; j < 4; ++j) if (v0 + j < count) { const int vv = v0 + j; const TrTile t = tr_decode(P, base + (vv < split_at ? vv : vv + jump)); const int n = tid >> 3, kq = tid & 7; const float* tp = tile + j * 4160 + (kq * 8) * 65 + n;
            u32x4 pk; pk[0] = pk_bf16(tp[0], tp[65]); pk[1] = pk_bf16(tp[130], tp[195]); pk[2] = pk_bf16(tp[260], tp[325]); pk[3] = pk_bf16(tp[390], tp[455]);
            *(u32x4*)(t.dst + (size_t)(t.drow + n) * t.K + t.k0 + kq * 8) = pk; }
    }
    __syncthreads();
}
__device__ __forceinline__ void convert_by_idle(const Params& P, int items, int count, int base, int split_at, int jump, unsigned char* lds) {
    const int G = (int)gridDim.x, c = (int)blockIdx.x; const int first = items < G ? items : items % G;
    if (first == 0 || first >= G) convert_range(P, count, base, split_at, jump, c, G, lds);
    else if (c >= first) convert_range(P, count, base, split_at, jump, c - first, G - first, lds);
}

__device__ __forceinline__ void prep_phase(const Params& P, unsigned char* lds) {
    float* tile = (float*)lds; unsigned char* ws = P.ws;
    const int tid = opaque_tid(), wid = tid >> 6, lane = tid & 63;
    const int gtid = blockIdx.x * 512 + tid, gsz = gridDim.x * 512;
    for (int row0 = blockIdx.x * 8 + wid; row0 < TT; row0 += gridDim.x * 8 * 4) {
        float4 v[4][4];
#pragma unroll
        for (int q = 0; q < 4; ++q) { const int row = row0 + q * gridDim.x * 8; if (row < TT) { const float* xr = row < TP ? P.in[0] + (size_t)row * 1024 : P.in[1] + (size_t)(row - TP) * 1024;
#pragma unroll
            for (int j = 0; j < 4; ++j) v[q][j] = *(const float4*)(xr + j * 256 + lane * 4); } }
#pragma unroll
        for (int q = 0; q < 4; ++q) { const int row = row0 + q * gridDim.x * 8; if (row < TT) { bf16_t* xb = (bf16_t*)(ws + OFF_XB) + (size_t)row * 1024; float s = 0.f;
#pragma unroll
            for (int j = 0; j < 4; ++j) { const float4 w = v[q][j]; s += w.x * w.x + w.y * w.y + w.z * w.z + w.w * w.w;
                u32x2 pk; pk[0] = pk_bf16(w.x, w.y); pk[1] = pk_bf16(w.z, w.w); *(u32x2*)(xb + j * 256 + lane * 4) = pk; }
#pragma unroll
            for (int o = 1; o < 64; o <<= 1) s += __shfl_xor(s, o);
            if (lane == 0) ((float*)(ws + OFF_SS))[row] = s; } }
    }
    for (int i = gtid; i < 4 * TT; i += gsz) ((float*)(ws + OFF_SS))[TT + i] = 0.f;
    for (int i = gtid; i < 2 * 2 * 8 * 4096; i += gsz) { const int e = i & 4095, hh = (i >> 12) & 7, which = (i >> 15) & 1, l = i >> 16, j = e >> 6, ii = e & 63;
        const float* w = which ? P.in[12] : P.in[10]; ((bf16_t*)(ws + OFF_WAX))[i] = f2bf(w[((size_t)(l * 8 + hh) * 64 + ii) * 64 + j]); }
    for (int i = gtid; i < 4096 * 16; i += gsz) { const int h = i & 15, lgp = i >> 4, l = lgp >> 11, gp = lgp & 2047, g = gp >> 6, p = gp & 63;
        const float lr = P.in[15][lgp], li = P.in[16][lgp], dt = expf(P.in[22][l * 32 + g]);
        const float mag = expf(lr * dt), lbr = mag * cosf(li * dt), lbi = mag * sinf(li * dt);
        const float nr = lbr - 1.f, ni = lbi, den = lr * lr + li * li, gr = (nr * lr + ni * li) / den, gi = (ni * lr - nr * li) / den;
        const float br = P.in[17][(size_t)lgp * 16 + h], bi = P.in[18][(size_t)lgp * 16 + h];
        bf16_t* bb = (bf16_t*)(ws + OFF_BB) + ((size_t)(l * 32 + g) * 128) * 16;
        bb[(size_t)p * 16 + h] = f2bf(gr * br - gi * bi); bb[(size_t)(64 + p) * 16 + h] = f2bf(gr * bi + gi * br);
        bf16_t* cm = (bf16_t*)(ws + OFF_CM) + ((size_t)(l * 32 + g) * 16) * 128;
        cm[h * 128 + 2 * p] = f2bf(P.in[19][((size_t)(l * 32 + g) * 16 + h) * 64 + p]); cm[h * 128 + 2 * p + 1] = f2bf(-P.in[20][((size_t)(l * 32 + g) * 16 + h) * 64 + p]);
        if (h == 0) { float pr = lbr, pi = lbi;
            for (int sq = 0; sq < 5; ++sq) { const float t = pr * pr - pi * pi; pi = 2.f * pr * pi; pr = t; }
            float* lb = (float*)(ws + OFF_LB) + (size_t)l * 4 * 2048; lb[gp] = lbr; lb[2048 + gp] = lbi; lb[4096 + gp] = pr; lb[6144 + gp] = pi; } }
    { const int coff = (int)gridDim.x >= 256 ? 144 : 0;
      if ((int)blockIdx.x >= coff) convert_range(P, 448, 0, 384, 2368, (int)blockIdx.x - coff, (int)gridDim.x - coff, lds); }
}

__device__ __forceinline__ void norm_store(const bf16_t* gtile, bf16_t* dst) {
    const int tid = opaque_tid(), tok = tid >> 4, part = tid & 15; const bf16_t* src = gtile + tok * 520 + part * 32;
    float v[32]; float s = 0.f;
#pragma unroll
    for (int q = 0; q < 4; ++q) { const u32x4 w = *(const u32x4*)(src + q * 8);
#pragma unroll
        for (int e = 0; e < 4; ++e) { const float a = __uint_as_float(w[e] << 16), b = __uint_as_float(w[e] & 0xFFFF0000u); v[q * 8 + e * 2] = a; v[q * 8 + e * 2 + 1] = b; s += a * a + b * b; } }
    s += __shfl_xor(s, 1); s += __shfl_xor(s, 2); s += __shfl_xor(s, 4); s += __shfl_xor(s, 8);
    const float rs = rsqrtf(s * (1.f / 512.f) + EPS);
    bf16_t* d = dst + (size_t)tok * 1024 + part * 32;
#pragma unroll
    for (int q = 0; q < 4; ++q) { u32x4 pk;
#pragma unroll
        for (int e = 0; e < 4; ++e) pk[e] = pk_bf16(v[q * 8 + e * 2] * rs, v[q * 8 + e * 2 + 1] * rs);
        *(u32x4*)(d + q * 8) = pk; }
}

struct S5G { bf16x4 bbf[8]; bf16x8 cmf[4]; bf16x4 uf[2]; bf16x4 df; float lbr, lbi, xr, xi; };
template <bool FINAL>
__device__ __forceinline__ void s5_load(S5G& G, const Params& P, int l, int g, int row0, bool samp, int sb, int tile, int lane) {
    unsigned char* ws = P.ws; const int fr = lane & 15, fq = lane >> 4, p = lane;
    const float* lb = (const float*)(ws + OFF_LB) + (size_t)l * 4 * 2048;
    G.lbr = lb[g * 64 + p]; G.lbi = lb[2048 + g * 64 + p]; G.xr = 0.f; G.xi = 0.f; G.df = (bf16x4){0, 0, 0, 0};
    if (FINAL) { if (samp) { G.xr = P.in[4][((size_t)(l * 8 + sb) * 32 + g) * 64 + p]; G.xi = P.in[5][((size_t)(l * 8 + sb) * 32 + g) * 64 + p]; }
                 else { const float* cc = (const float*)(ws + OFF_S5C) + (size_t)tile * 4096; G.xr = cc[g * 64 + p]; G.xi = cc[2048 + g * 64 + p]; } }
    const bf16_t* bb = (const bf16_t*)(ws + OFF_BB) + ((size_t)(l * 32 + g) * 128) * 16;
#pragma unroll
    for (int nt = 0; nt < 8; ++nt) G.bbf[nt] = *(const bf16x4*)(bb + (size_t)(nt * 16 + fr) * 16 + fq * 4);
    const bf16_t* Z = (const bf16_t*)(ws + OFF_Z);
    if (FINAL) { const bf16_t* cm = (const bf16_t*)(ws + OFF_CM) + ((size_t)(l * 32 + g) * 16 + fr) * 128;
#pragma unroll
        for (int kk = 0; kk < 4; ++kk) G.cmf[kk] = *(const bf16x8*)(cm + kk * 32 + fq * 8);
        { const short dv = (short)f2bf(P.in[21][l * 512 + g * 16 + fr]); G.df[0] = (fq * 4 + 0 == fr) ? dv : (short)0; G.df[1] = (fq * 4 + 1 == fr) ? dv : (short)0; G.df[2] = (fq * 4 + 2 == fr) ? dv : (short)0; G.df[3] = (fq * 4 + 3 == fr) ? dv : (short)0; } }
#pragma unroll
    for (int sub = 0; sub < 2; ++sub) { const bf16_t* zu = Z + (size_t)(row0 + sub * 16) * INW + 1024 + g * 16;
        G.uf[sub] = *(const bf16x4*)(zu + (size_t)fr * INW + fq * 4);
    }
}

__device__ __forceinline__ void lru_final_fast(const Params& P, int l, int tile, int tid) {
    unsigned char* ws = P.ws; const int tok = tid >> 4, part = tid & 15, row = tile * 32 + tok;
    const unsigned* hl = (const unsigned*)(ws + OFF_HL) + (size_t)(row >> 1) * 512 + part * 32; const unsigned* pl = (const unsigned*)(ws + OFF_PL) + (size_t)(row >> 1) * 512 + part * 32;
    const bf16_t* gz = (const bf16_t*)(ws + OFF_Z) + (size_t)row * INW + 512 + part * 32; const float* cc = (const float*)(ws + OFF_LRUC) + (size_t)tile * 512 + part * 32;
    u32x4 hv[8], pv[8], gv[4]; f32x4 cv[8];
#pragma unroll
    for (int q = 0; q < 8; ++q) { hv[q] = *(const u32x4*)(hl + q * 4); pv[q] = *(const u32x4*)(pl + q * 4); cv[q] = *(const f32x4*)(cc + q * 4); }
#pragma unroll
    for (int q = 0; q < 4; ++q) gv[q] = *(const u32x4*)(gz + q * 8);
    const bool odd = row & 1;
    float v[32]; float sq = 0.f;
#pragma unroll
    for (int ci = 0; ci < 32; ++ci) {
        const unsigned hw = hv[ci >> 2][ci & 3], pw = pv[ci >> 2][ci & 3], gw = gv[ci >> 3][(ci >> 1) & 3];
        const float h0 = odd ? __uint_as_float(hw & 0xFFFF0000u) : __uint_as_float(hw << 16), p0 = odd ? __uint_as_float(pw & 0xFFFF0000u) : __uint_as_float(pw << 16),
                    g0 = (ci & 1) ? __uint_as_float(gw & 0xFFFF0000u) : __uint_as_float(gw << 16);
        const float y = (h0 + p0 * cv[ci >> 2][ci & 3]) * gelu_t(g0); v[ci] = y; sq += y * y; }
    sq += __shfl_xor(sq, 1); sq += __shfl_xor(sq, 2); sq += __shfl_xor(sq, 4); sq += __shfl_xor(sq, 8);
    const float rs = rsqrtf(sq * (1.f / 512.f) + EPS);
    bf16_t* d = (bf16_t*)(ws + OFF_MIX) + (size_t)row * 1024 + part * 32;
#pragma unroll
    for (int q = 0; q < 4; ++q) { u32x4 pk;
#pragma unroll
        for (int e = 0; e < 4; ++e) pk[e] = pk_bf16(v[q * 8 + e * 2] * rs, v[q * 8 + e * 2 + 1] * rs);
        *(u32x4*)(d + q * 8) = pk; }
    if (tile == NPT - 1) {
        const int c = tid; const bf16_t* zp = (const bf16_t*)(ws + OFF_Z) + (size_t)(TP - 3) * INW + c; float* oc = P.out + O_CONV_P + (size_t)l * 3 * 512;
        oc[c] = bf2f(zp[0]); oc[512 + c] = bf2f(zp[INW]); oc[1024 + c] = bf2f(zp[2 * INW]);
        P.out[O_LRU_P + (size_t)l * 512 + c] = ((const float*)(ws + OFF_LRUB))[(size_t)tile * 512 + c] + ((const float*)(ws + OFF_LRUA))[(size_t)tile * 512 + c] * ((const float*)(ws + OFF_LRUC))[(size_t)tile * 512 + c];
    }
}

template <bool FINAL, bool FAST = false>
__device__ __forceinline__ void mixer_tile(const Params& P, int l, int tile, unsigned char* lds, const int flags = 3) {
    const int tid = opaque_tid(), wid = tid >> 6, lane = tid & 63, fr = lane & 15, fq = lane >> 4;
    unsigned char* ws = P.ws;
    const bool samp = tile >= NPT; const int sb = tile - NPT;
    const int row0 = samp ? TP + sb * 32 : tile * 32;
    const bool seq_start = samp || tile == 0, seq_end = samp || tile == NPT - 1;
    bf16_t* gtile = (bf16_t*)lds;
    unsigned char* wsc = lds + LDS_GT + wid * LDS_WSC;
    float* regA = (float*)wsc; bf16_t* regB = (bf16_t*)(wsc + LDS_RA);
    const bf16_t* Z = (const bf16_t*)(ws + OFF_Z);
    bf16_t* MIX = (bf16_t*)(ws + OFF_MIX);
    __syncthreads();
    S5G cur;
    if (FAST) { lru_final_fast(P, l, tile, tid); s5_load<FINAL>(cur, P, l, wid * 4, row0, samp, sb, tile, lane); }
    else if (flags & 1) {
        const int c = wid * 64 + lane;
        const bf16_t* zc = Z + (size_t)row0 * INW + c;
        unsigned xraw[16];
#pragma unroll
        for (int t = 0; t < 16; ++t) xraw[t] = (unsigned)zc[(size_t)(2 * t) * INW] | ((unsigned)zc[(size_t)(2 * t + 1) * INW] << 16);
        float x3, x2, x1;
        if (seq_start) { if (samp) { const float* sc = P.in[2] + ((size_t)(l * 8 + sb) * 3) * 512; x3 = sc[c]; x2 = sc[512 + c]; x1 = sc[1024 + c]; } else { x3 = 0.f; x2 = 0.f; x1 = 0.f; } }
        else { const bf16_t* zp = Z + (size_t)(row0 - 3) * INW + c; x3 = bf2f(zp[0]); x2 = bf2f(zp[INW]); x1 = bf2f(zp[2 * INW]); }
        if (FINAL) {
#pragma unroll
            for (int t = 0; t < 32; ++t) gtile[t * 520 + c] = zc[(size_t)t * INW + 512];
        }
        const float* cw = P.in[8] + (size_t)l * 4 * 512; const float cw0 = cw[c], cw1 = cw[512 + c], cw2 = cw[1024 + c], cw3 = cw[1536 + c];
        const float cb = P.in[9][l * 512 + c], ba = P.in[11][l * 512 + c], bx = P.in[13][l * 512 + c];
        const float sp8 = -8.f * log1pf(__expf(-P.in[14][l * 512 + c]));
        float h = 0.f, Pa = 1.f;
        if (FINAL) h = samp ? P.in[3][(size_t)(l * 8 + sb) * 512 + c] : ((const float*)(ws + OFF_LRUC))[(size_t)tile * 512 + c];
        const bf16_t* wa = (const bf16_t*)(ws + OFF_WAX) + ((size_t)(l * 2 + 0) * 8 + wid) * 4096;
        const bf16_t* wx = (const bf16_t*)(ws + OFF_WAX) + ((size_t)(l * 2 + 1) * 8 + wid) * 4096;
        bf16x8 waf[4][2], wxf[4][2];
#pragma unroll
        for (int jt = 0; jt < 4; ++jt)
#pragma unroll
            for (int kk = 0; kk < 2; ++kk) { waf[jt][kk] = *(const bf16x8*)(wa + (jt * 16 + fr) * 64 + kk * 32 + fq * 8); wxf[jt][kk] = *(const bf16x8*)(wx + (jt * 16 + fr) * 64 + kk * 32 + fq * 8); }
        s5_load<FINAL>(cur, P, l, wid * 4, row0, samp, sb, tile, lane);
        bf16_t* xcs = regB; float* pre = regA;
#pragma unroll
        for (int sub = 0; sub < 2; ++sub) {
#pragma unroll
            for (int tt = 0; tt < 16; ++tt) { const float x0 = (tt & 1) ? __uint_as_float(xraw[sub * 8 + (tt >> 1)] & 0xFFFF0000u) : __uint_as_float(xraw[sub * 8 + (tt >> 1)] << 16); const float xc = cb + cw0 * x3 + cw1 * x2 + cw2 * x1 + cw3 * x0; x3 = x2; x2 = x1; x1 = x0; xcs[tt * 72 + lane] = f2bf(xc); }
            WAVE_SYNC();
            f32x4 aa[4], ax[4];
#pragma unroll
            for (int jt = 0; jt < 4; ++jt) { aa[jt] = (f32x4){0.f, 0.f, 0.f, 0.f}; ax[jt] = (f32x4){0.f, 0.f, 0.f, 0.f}; }
#pragma unroll
            for (int kk = 0; kk < 2; ++kk) { const bf16x8 bfv = *(const bf16x8*)(xcs + fr * 72 + kk * 32 + fq * 8);
#pragma unroll
                for (int jt = 0; jt < 4; ++jt) { aa[jt] = __builtin_amdgcn_mfma_f32_16x16x32_bf16(bfv, waf[jt][kk], aa[jt], 0, 0, 0); ax[jt] = __builtin_amdgcn_mfma_f32_16x16x32_bf16(bfv, wxf[jt][kk], ax[jt], 0, 0, 0); } }
#pragma unroll
            for (int jt = 0; jt < 4; ++jt) { *(f32x4*)(pre + (jt * 16 + fr) * 20 + fq * 4) = aa[jt]; *(f32x4*)(pre + 1280 + (jt * 16 + fr) * 20 + fq * 4) = ax[jt]; }
            WAVE_SYNC();
#pragma unroll 2
            for (int q = 0; q < 4; ++q) {
                typedef float f32x2 __attribute__((ext_vector_type(2)));
                const f32x4 pa4 = *(const f32x4*)(pre + lane * 20 + q * 4), px4 = *(const f32x4*)(pre + 1280 + lane * 20 + q * 4);
                const float NL2E = -1.4426950408889634f, sp8l = sp8 * 1.4426950408889634f;
#pragma unroll
                for (int ep = 0; ep < 2; ++ep) { const int tt = q * 4 + 2 * ep;
                    const f32x2 ua = ((f32x2){pa4[2 * ep], pa4[2 * ep + 1]} + (f32x2){ba, ba}) * NL2E, ux = ((f32x2){px4[2 * ep], px4[2 * ep + 1]} + (f32x2){bx, bx}) * NL2E;
                    const f32x2 da = (f32x2){__builtin_amdgcn_exp2f(ua[0]), __builtin_amdgcn_exp2f(ua[1])} + 1.f, dx = (f32x2){__builtin_amdgcn_exp2f(ux[0]), __builtin_amdgcn_exp2f(ux[1])} + 1.f;
                    const f32x2 rg = (f32x2){__builtin_amdgcn_rcpf(da[0]), __builtin_amdgcn_rcpf(da[1])}, ig = (f32x2){__builtin_amdgcn_rcpf(dx[0]), __builtin_amdgcn_rcpf(dx[1])};
                    const f32x2 la = rg * sp8l, av = (f32x2){__builtin_amdgcn_exp2f(la[0]), __builtin_amdgcn_exp2f(la[1])};
                    const f32x2 om = 1.f - av * av;
                    const f32x2 xc = (f32x2){bf2f(xcs[tt * 72 + lane]), bf2f(xcs[(tt + 1) * 72 + lane])};
                    const f32x2 bv = (f32x2){__builtin_amdgcn_sqrtf(fmaxf(om[0], 0.f)), __builtin_amdgcn_sqrtf(fmaxf(om[1], 0.f))} * (ig * xc);
                    const float h0 = av[0] * h + bv[0], p0 = Pa * av[0]; h = av[1] * h0 + bv[1]; Pa = p0 * av[1];
                    if (!FINAL) { ((unsigned*)(ws + OFF_HL))[(size_t)((row0 + sub * 16 + tt) >> 1) * 512 + c] = pk_bf16(h0, h); ((unsigned*)(ws + OFF_PL))[(size_t)((row0 + sub * 16 + tt) >> 1) * 512 + c] = pk_bf16(p0, Pa); }
                    if (FINAL) { bf16_t* gp = gtile + (sub * 16 + tt) * 520 + c; const float gl0 = bf2f(gp[0]), gl1 = bf2f(gp[520]); gp[0] = f2bf(h0 * gelu_t(gl0)); gp[520] = f2bf(h * gelu_t(gl1)); } }
            }
            WAVE_SYNC();
        }
        if (!FINAL) { ((float*)(ws + OFF_LRUA))[(size_t)tile * 512 + c] = Pa; ((float*)(ws + OFF_LRUB))[(size_t)tile * 512 + c] = h; }
        else if (seq_end) {
            float* oc = P.out + (samp ? O_CONV_S + ((size_t)(l * 8 + sb) * 3) * 512 : O_CONV_P + (size_t)l * 3 * 512);
            oc[c] = x3; oc[512 + c] = x2; oc[1024 + c] = x1;
            P.out[(samp ? O_LRU_S + (size_t)(l * 8 + sb) * 512 : O_LRU_P + (size_t)l * 512) + c] = h;
        }
    if (FINAL) { __syncthreads(); norm_store(gtile, MIX + (size_t)row0 * 1024); __syncthreads(); }
    }
    else s5_load<FINAL>(cur, P, l, wid * 4, row0, samp, sb, tile, lane);
    if (flags & 2) {
#pragma unroll
    for (int gi = 0; gi < 4; ++gi) {
        const int g = wid * 4 + gi, p = lane;
        S5G nxt;
        if (gi < 3) s5_load<FINAL>(nxt, P, l, g + 1, row0, samp, sb, tile, lane);
        float xr = cur.xr, xi = cur.xi; const float lbr = cur.lbr, lbi = cur.lbi;
        float* Bu = regA; bf16_t* xs = regB;
#pragma unroll
        for (int sub = 0; sub < 2; ++sub) {
#pragma unroll
            for (int ntp = 0; ntp < 4; ++ntp) {
                const f32x4 dr = __builtin_amdgcn_mfma_f32_16x16x16bf16_1k(cur.uf[sub], cur.bbf[ntp], (f32x4){0.f, 0.f, 0.f, 0.f}, 0, 0, 0);
                const f32x4 di = __builtin_amdgcn_mfma_f32_16x16x16bf16_1k(cur.uf[sub], cur.bbf[ntp + 4], (f32x4){0.f, 0.f, 0.f, 0.f}, 0, 0, 0);
                float* bp = Bu + (ntp * 16 + fr) * 36 + fq * 8;
                *(f32x4*)bp = (f32x4){dr[0], di[0], dr[1], di[1]}; *(f32x4*)(bp + 4) = (f32x4){dr[2], di[2], dr[3], di[3]}; }
            WAVE_SYNC();
            {
                typedef float f32x2 __attribute__((ext_vector_type(2)));
                f32x2 X = (f32x2){xr, xi}; const f32x2 LA = (f32x2){lbr, lbr}, LB = (f32x2){-lbi, lbi};
#pragma unroll
                for (int q = 0; q < 8; ++q) { const f32x4 b4 = *(const f32x4*)(Bu + p * 36 + q * 4);
#pragma unroll
                    for (int e = 0; e < 2; ++e) { const f32x2 bin = (f32x2){b4[2 * e], b4[2 * e + 1]};
                        X = LA * X + (LB * __builtin_shufflevector(X, X, 1, 0) + bin);
                        if (FINAL) ((unsigned*)xs)[(q * 2 + e) * 68 + p] = pk_bf16(X[0], X[1]); } }
                xr = X[0]; xi = X[1];
            }
            if (FINAL) {
                WAVE_SYNC();
                const f32x4 yd = __builtin_amdgcn_mfma_f32_16x16x16bf16_1k(cur.uf[sub], cur.df, (f32x4){0.f, 0.f, 0.f, 0.f}, 0, 0, 0);
                f32x4 y = (f32x4){0.f, 0.f, 0.f, 0.f};
#pragma unroll
                for (int kk = 0; kk < 4; ++kk) { const bf16x8 af = *(const bf16x8*)(xs + fr * 136 + kk * 32 + fq * 8); y = __builtin_amdgcn_mfma_f32_16x16x32_bf16(af, cur.cmf[kk], y, 0, 0, 0); }
#pragma unroll
                for (int r = 0; r < 4; ++r) { const int tok = fq * 4 + r; gtile[(sub * 16 + tok) * 520 + g * 16 + fr] = f2bf(gelu_t(y[r] + yd[r])); }
            }
            WAVE_SYNC();
        }
        if (!FINAL) { float* e = (float*)(ws + OFF_S5E) + (size_t)tile * 4096; e[g * 64 + p] = xr; e[2048 + g * 64 + p] = xi; }
        else if (seq_end) { const size_t o = samp ? ((size_t)(l * 8 + sb) * 32 + g) * 64 + p : ((size_t)l * 32 + g) * 64 + p;
            P.out[(samp ? O_RE_S : O_RE_P) + o] = xr; P.out[(samp ? O_IM_S : O_IM_P) + o] = xi; }
        if (gi < 3) cur = nxt;
    }
    if (FINAL) {
        const bf16_t* wg = (const bf16_t*)(ws + OFF_WGLU + l * SZ_WGLU) + (size_t)(wid * 64 + fr) * 512 + fq * 8;
        bf16x8 bq[2][4][4];
#pragma unroll
        for (int cb = 0; cb < 2; ++cb)
#pragma unroll
            for (int k4 = 0; k4 < 4; ++k4)
#pragma unroll
                for (int nt = 0; nt < 4; ++nt) bq[cb][k4][nt] = *(const bf16x8*)(wg + (size_t)nt * 16 * 512 + (cb * 4 + k4) * 32);
        float bg[4];
#pragma unroll
        for (int nt = 0; nt < 4; ++nt) bg[nt] = P.in[24][l * 512 + wid * 64 + nt * 16 + fr];
        __syncthreads();
        f32x4 acc[2][4];
#pragma unroll
        for (int mt = 0; mt < 2; ++mt)
#pragma unroll
            for (int nt = 0; nt < 4; ++nt) acc[mt][nt] = (f32x4){0.f, 0.f, 0.f, 0.f};
#pragma unroll
        for (int ch = 0; ch < 4; ++ch) {
#pragma unroll
            for (int k4 = 0; k4 < 4; ++k4) { const int kk = ch * 4 + k4;
                bf16x8 af[2];
#pragma unroll
                for (int mt = 0; mt < 2; ++mt) af[mt] = *(const bf16x8*)(gtile + (mt * 16 + fr) * 520 + kk * 32 + fq * 8);
#pragma unroll
                for (int mt = 0; mt < 2; ++mt)
#pragma unroll
                    for (int nt = 0; nt < 4; ++nt) acc[mt][nt] = __builtin_amdgcn_mfma_f32_16x16x32_bf16(af[mt], bq[ch & 1][k4][nt], acc[mt][nt], 0, 0, 0); }
            if (ch < 2) {
#pragma unroll
                for (int k4 = 0; k4 < 4; ++k4)
#pragma unroll
                    for (int nt = 0; nt < 4; ++nt) bq[ch & 1][k4][nt] = *(const bf16x8*)(wg + (size_t)nt * 16 * 512 + ((ch + 2) * 4 + k4) * 32); }
        }
        float o[2][4][4];
#pragma unroll
        for (int mt = 0; mt < 2; ++mt)
#pragma unroll
            for (int nt = 0; nt < 4; ++nt) { const int n = wid * 64 + nt * 16 + fr;
#pragma unroll
                for (int r = 0; r < 4; ++r) o[mt][nt][r] = bf2f(gtile[(mt * 16 + fq * 4 + r) * 520 + n]) * sigm(acc[mt][nt][r] + bg[nt]); }
        __syncthreads();
#pragma unroll
        for (int mt = 0; mt < 2; ++mt)
#pragma unroll
            for (int nt = 0; nt < 4; ++nt)
#pragma unroll
                for (int r = 0; r < 4; ++r) gtile[(mt * 16 + fq * 4 + r) * 520 + wid * 64 + nt * 16 + fr] = f2bf(o[mt][nt][r]);
        __syncthreads();
        norm_store(gtile, MIX + (size_t)row0 * 1024 + 512);
    }
    }
}

__device__ __forceinline__ void carry_phase(const Params& P, int l, unsigned char* lds, const int nitems) {
    unsigned char* ws = P.ws; const int tid = opaque_tid(); const int seg = tid >> 4, ch = tid & 15;
    float* sl = (float*)lds;
    for (int it = blockIdx.x; it < nitems; it += gridDim.x) {
        if (it < 32) {
            const int c = it * 16 + ch; const float* A = (const float*)(ws + OFF_LRUA) + (size_t)(seg * 16) * 512 + c; const float* B = (const float*)(ws + OFF_LRUB) + (size_t)(seg * 16) * 512 + c;
            float a[16], b[16];
#pragma unroll
            for (int k = 0; k < 16; ++k) { a[k] = A[(size_t)k * 512]; b[k] = B[(size_t)k * 512]; }
            float pa = 1.f, pb = 0.f;
#pragma unroll
            for (int k = 0; k < 16; ++k) { pb = a[k] * pb + b[k]; pa *= a[k]; }
            __syncthreads();
            sl[seg * 16 + ch] = pa; sl[512 + seg * 16 + ch] = pb;
            __syncthreads();
            float cs = 0.f;
            for (int s2 = 0; s2 < seg; ++s2) cs = sl[s2 * 16 + ch] * cs + sl[512 + s2 * 16 + ch];
            float* C = (float*)(ws + OFF_LRUC) + (size_t)(seg * 16) * 512 + c;
#pragma unroll
            for (int k = 0; k < 16; ++k) { C[(size_t)k * 512] = cs; cs = a[k] * cs + b[k]; }
        } else if (it < 160) {
            const int idx = (it - 32) * 16 + ch; const float* lb = (const float*)(ws + OFF_LB) + (size_t)l * 4 * 2048; const float qr = lb[4096 + idx], qi = lb[6144 + idx];
            const float* E = (const float*)(ws + OFF_S5E) + (size_t)(seg * 16) * 4096 + idx;
            float er[16], ei[16];
#pragma unroll
            for (int k = 0; k < 16; ++k) { er[k] = E[(size_t)k * 4096]; ei[k] = E[(size_t)k * 4096 + 2048]; }
            float xr = 0.f, xi = 0.f;
#pragma unroll
            for (int k = 0; k < 16; ++k) { const float nr = qr * xr - qi * xi + er[k], ni = qr * xi + qi * xr + ei[k]; xr = nr; xi = ni; }
            float q16r = qr, q16i = qi;
#pragma unroll
            for (int s2 = 0; s2 < 4; ++s2) { const float t = q16r * q16r - q16i * q16i; q16i = 2.f * q16r * q16i; q16r = t; }
            __syncthreads();
            sl[seg * 16 + ch] = xr; sl[512 + seg * 16 + ch] = xi;
            __syncthreads();
            float cr = 0.f, ci = 0.f;
            for (int s2 = 0; s2 < seg; ++s2) { const float nr = q16r * cr - q16i * ci + sl[s2 * 16 + ch], ni = q16r * ci + q16i * cr + sl[512 + s2 * 16 + ch]; cr = nr; ci = ni; }
            float* C = (float*)(ws + OFF_S5C) + (size_t)(seg * 16) * 4096 + idx;
#pragma unroll
            for (int k = 0; k < 16; ++k) { C[(size_t)k * 4096] = cr; C[(size_t)k * 4096 + 2048] = ci; const float nr = qr * cr - qi * ci + er[k], ni = qr * ci + qi * cr + ei[k]; cr = nr; ci = ni; }
        } else mixer_tile<true>(P, l, NPT + ((it - 160) & 7), lds, it < 168 ? 1 : 2);
    }
}

__device__ __forceinline__ void final_norm(const Params& P) {
    const float* ss = (const float*)(P.ws + OFF_SS) + 4 * TT; const int tid = opaque_tid(); const bf16_t* XB = (const bf16_t*)(P.ws + OFF_XB);
    const int cg = (tid & 127) * 8;
    const float4 g0 = *(const float4*)(P.in[32] + cg), g1 = *(const float4*)(P.in[32] + cg + 4);
    for (int r0 = blockIdx.x * 4 + (tid >> 7); r0 < TP; r0 += gridDim.x * 4 * 4) {
        u32x4 w[4]; float rs[4];
#pragma unroll
        for (int j = 0; j < 4; ++j) { const int row = r0 + j * gridDim.x * 4; if (row < TP) { w[j] = *(const u32x4*)(XB + (size_t)row * 1024 + cg); rs[j] = ss[row]; } }
#pragma unroll
        for (int j = 0; j < 4; ++j) { const int row = r0 + j * gridDim.x * 4; if (row < TP) { const float q = rsqrtf(rs[j] * (1.f / 1024.f) + EPS); float4 a, b;
            a.x = __uint_as_float(w[j][0] << 16) * q * g0.x; a.y = __uint_as_float(w[j][0] & 0xFFFF0000u) * q * g0.y; a.z = __uint_as_float(w[j][1] << 16) * q * g0.z; a.w = __uint_as_float(w[j][1] & 0xFFFF0000u) * q * g0.w;
            b.x = __uint_as_float(w[j][2] << 16) * q * g1.x; b.y = __uint_as_float(w[j][2] & 0xFFFF0000u) * q * g1.y; b.z = __uint_as_float(w[j][3] << 16) * q * g1.z; b.w = __uint_as_float(w[j][3] & 0xFFFF0000u) * q * g1.w;
            *(float4*)(P.out + (size_t)row * 1024 + cg) = a; *(float4*)(P.out + (size_t)row * 1024 + cg + 4) = b; } }
    }
    const int wid = tid >> 6, lane = tid & 63;
    for (int r = blockIdx.x + wid * gridDim.x; r < 256; r += gridDim.x * 8) { const bf16_t* xb = XB + (size_t)(TP + r) * 1024; float* xr = P.out + (size_t)(TP + r) * 1024; float4 v[4]; float sq = 0.f;
#pragma unroll
        for (int j = 0; j < 4; ++j) { const u32x2 w = *(const u32x2*)(xb + j * 256 + lane * 4); v[j].x = __uint_as_float(w[0] << 16); v[j].y = __uint_as_float(w[0] & 0xFFFF0000u); v[j].z = __uint_as_float(w[1] << 16); v[j].w = __uint_as_float(w[1] & 0xFFFF0000u); }
        for (int s0 = 0; s0 < 11; s0 += 4) {
            float4 w[4][4];
#pragma unroll
            for (int b = 0; b < 4; ++b) if (s0 + b < 11) { const float* pr = (const float*)(P.ws + OFF_PART) + ((size_t)(s0 + b) * 256 + r) * 1024;
#pragma unroll
                for (int j = 0; j < 4; ++j) w[b][j] = *(const float4*)(pr + j * 256 + lane * 4); }
#pragma unroll
            for (int b = 0; b < 4; ++b) if (s0 + b < 11) {
#pragma unroll
                for (int j = 0; j < 4; ++j) { v[j].x += w[b][j].x; v[j].y += w[b][j].y; v[j].z += w[b][j].z; v[j].w += w[b][j].w; } } }
#pragma unroll
        for (int j = 0; j < 4; ++j) sq += v[j].x * v[j].x + v[j].y * v[j].y + v[j].z * v[j].z + v[j].w * v[j].w;
#pragma unroll
        for (int o = 1; o < 64; o <<= 1) sq += __shfl_xor(sq, o);
        const float rs = rsqrtf(sq * (1.f / 1024.f) + EPS);
#pragma unroll
        for (int j = 0; j < 4; ++j) { const float4 g = *(const float4*)(P.in[32] + j * 256 + lane * 4); v[j].x *= rs * g.x; v[j].y *= rs * g.y; v[j].z *= rs * g.z; v[j].w *= rs * g.w; *(float4*)(xr + j * 256 + lane * 4) = v[j]; } }
}

#define GSYNC() do { XcdBarrier xb_; xb_.bar = (unsigned*)(P.ws + OFF_BAR); xb_.x = (unsigned)__builtin_amdgcn_readfirstlane((int)xb_xcc_id()); xb_.st = (volatile LAS unsigned*)(shm + LDS_XB); xcd_barrier(xb_); } while (0)
__global__ void __launch_bounds__(512, 2) hymba_fwd(Params P) {
    extern __shared__ __attribute__((aligned(16))) unsigned char shm[];
    cg::grid_group grid = cg::this_grid();
    unsigned char* ws = P.ws;
    float* ss = (float*)(ws + OFF_SS);
    bf16_t* XB = (bf16_t*)(ws + OFF_XB);
    unsigned* ctrs = (unsigned*)(ws + OFF_BAR) + CTR_WORD0;
    if (threadIdx.x < 4) ((volatile unsigned*)(shm + LDS_XB))[threadIdx.x] = 0u;
    __syncthreads();
    if (threadIdx.x == 0) (void)xb_add(&((unsigned*)(ws + OFF_BAR))[XB_XCNT((unsigned)__builtin_amdgcn_readfirstlane((int)xb_xcc_id()))], 1u);
    if (P.out == nullptr) grid.sync();
    prep_phase(P, shm);
    GSYNC();
    for (int l = 0; l < 2; ++l) {
        if (l) sample_fix(P, 11, ss + (size_t)(2 * l) * TT, ctrs + 128);
        const int g1_first = (65 * 6) % (int)gridDim.x, g1_idle = (int)gridDim.x - g1_first; const bool early_sample = (65 * 6 > (int)gridDim.x) && g1_idle >= 32 && (int)gridDim.x >= 176;
        run_gemm_g1(shm, XB, (const bf16_t*)(ws + OFF_WIN + l * SZ_WIN), INW, DM, EpiZ{(bf16_t*)(ws + OFF_Z), ss + (size_t)(2 * l) * TT}, l ? ctrs + 128 : nullptr, early_sample ? ctrs + 192 + 64 * l : nullptr);
        if (early_sample) {
            const int rk = (int)blockIdx.x - g1_first;
            if (rk >= 0 && rk < 16) { wait_counter(ctrs + 192 + 64 * l, 6 * 8); mixer_tile<true>(P, l, NPT + (rk & 7), shm, rk < 8 ? 1 : 2); }
            else if (rk >= 16 && l == 0) convert_range(P, 1664, 384, 1664, 0, rk - 16, g1_idle - 16, shm);
        } else if (l == 0) convert_by_idle(P, 65 * 6, 1664, 384, 1664, 0, shm);
        GSYNC();
        for (int t = blockIdx.x; t < NPT; t += gridDim.x) mixer_tile<false>(P, l, t, shm);
        GSYNC();
        carry_phase(P, l, shm, early_sample ? 160 : 176);
        if (early_sample && (int)blockIdx.x >= 160 && (int)blockIdx.x < 176)
            run_gemm_sample_split(shm, (const bf16_t*)(ws + OFF_MIX), (const bf16_t*)(ws + OFF_WOUT + l * SZ_WOUT), DM, DM, 4, (int)blockIdx.x - 160, EpiRes{XB, ss + (size_t)(2 * l + 1) * TT, (float*)(ws + OFF_PART)});
        if (l == 0) convert_by_idle(P, 176, 704, 2048, 704, 0, shm);
        GSYNC();
        for (int t = blockIdx.x; t < NPT; t += gridDim.x) mixer_tile<true, true>(P, l, t, shm);
        GSYNC();
        if (early_sample) run_gemm(shm, (const bf16_t*)(ws + OFF_MIX), (const bf16_t*)(ws + OFF_WOUT + l * SZ_WOUT), TP, DM, DM, EpiRes{XB, ss + (size_t)(2 * l + 1) * TT, (float*)(ws + OFF_PART)}, nullptr);
        else run_gemm_split(shm, (const bf16_t*)(ws + OFF_MIX), (const bf16_t*)(ws + OFF_WOUT + l * SZ_WOUT), DM, DM, 4,
                 EpiRes{XB, ss + (size_t)(2 * l + 1) * TT, (float*)(ws + OFF_PART)});
        GSYNC();
        sample_fix(P, 4, ss + (size_t)(2 * l + 1) * TT, ctrs + 64 * l);
        run_gemm(shm, XB, (const bf16_t*)(ws + OFF_WGU + l * SZ_WGU), TT, NGU, DM, EpiFF{(bf16_t*)(ws + OFF_FF), ss + (size_t)(2 * l + 1) * TT}, ctrs + 64 * l);
        if (l == 0) convert_by_idle(P, 65 * 22, 1664, 2816 + 384, 1664, 0, shm);
        GSYNC();
        run_gemm_split(shm, (const bf16_t*)(ws + OFF_FF), (const bf16_t*)(ws + OFF_WDN + l * SZ_WDN), DM, DFF, 11,
                 EpiRes{XB, ss + (size_t)(2 * l + 2) * TT, (float*)(ws + OFF_PART)});
        if (l == 0) { convert_by_idle(P, 256 + 44, 768, 2816 + 2048, 768, 0, shm); convert_by_idle(P, 256 + 44, 384, 2816, 384, 0, shm); }
        GSYNC();
    }
    final_norm(P);
}

extern "C" void kernel_launch(void* const* d_in, const int* in_sizes, int n_in, void* d_out, int out_size, void* d_ws, size_t ws_size, hipStream_t stream) {
    static int grid = 0;
    if (grid == 0) {
        if (n_in != 33 || ws_size < WS_END) { fprintf(stderr, "kernel_launch: expected 33 inputs and >= %zu bytes of workspace (got %d, %zu)\n", (size_t)WS_END, n_in, ws_size); grid = -1; return; }
        int dev = 0, cus = 0, per_cu = 0;
        hipGetDevice(&dev); hipDeviceGetAttribute(&cus, hipDeviceAttributeMultiprocessorCount, dev);
        if (hipFuncSetAttribute((const void*)hymba_fwd, hipFuncAttributeMaxDynamicSharedMemorySize, LDS_BYTES) != hipSuccess) { fprintf(stderr, "kernel_launch: hipFuncSetAttribute failed\n"); grid = -1; return; }
        if (hipOccupancyMaxActiveBlocksPerMultiprocessor(&per_cu, (const void*)hymba_fwd, 512, LDS_BYTES) != hipSuccess || per_cu < 1) { fprintf(stderr, "kernel_launch: occupancy query gave %d\n", per_cu); per_cu = 1; }
        (void)hipGetLastError();
        grid = cus * per_cu;
    }
    if (grid < 0) return;
    if (hipMemsetAsync((unsigned char*)d_ws + OFF_BAR, 0, 16384, stream) != hipSuccess) { fprintf(stderr, "kernel_launch: memset of the barrier words failed\n"); return; }
    Params p{};
    for (int i = 0; i < 33; ++i) p.in[i] = (const float*)d_in[i];
    p.out = (float*)d_out; p.ws = (unsigned char*)d_ws;
    void* args[] = {&p};
    hipError_t e = hipLaunchCooperativeKernel((const void*)hymba_fwd, dim3(grid), dim3(512), args, LDS_BYTES, stream);
    if (e != hipSuccess) fprintf(stderr, "cooperative launch failed: %s (grid %d)\n", hipGetErrorString(e), grid);
}
```

```cpp
#include <hip/hip_runtime.h>
#include <hip/hip_cooperative_groups.h>
#include <cstdio>
namespace cg = cooperative_groups;

namespace pg8 {
#define PG8_LAS __attribute__((address_space(3)))
typedef unsigned short bf16_t;
typedef short bf16x8 __attribute__((ext_vector_type(8)));
typedef float f32x4 __attribute__((ext_vector_type(4)));
typedef unsigned u32x4 __attribute__((ext_vector_type(4)));
constexpr int BM = 256, BK = 64, HALF = 128, HTB = HALF * BK * 2  , STAGE_BYTES = 8 * HTB, NXCD = 8, WGM = 8;

__host__ __device__ __forceinline__ int lds_byte(int r, int c) { const int st = (r >> 4) * 2 + (c >> 5), rr = r & 15, cc = c & 31, ob = rr * 64 + cc * 2; return st * 1024 + (ob ^ (((ob >> 9) & 1) << 5)); }
__host__ __device__ __forceinline__ void stage_rc(int b, int& R, int& C) { const int st = b / 1024, sb = b % 1024, swz = sb ^ (((sb >> 9) & 1) << 5); R = (st >> 1) * 16 + swz / 64; C = (st & 1) * 32 + (swz % 64) / 2; }
__host__ __device__ __forceinline__ int perm32(int rho) { const int n = rho >> 4, i = rho & 15; return 8 * (i >> 2) + 4 * n + (i & 3); }

struct Unit { int pm, pn, k0t, nt, part; };
struct Gemm { const bf16_t* A; const bf16_t* Bt; int M, N, K; };

struct StaticOrder {
    int nM, nN, nwg, G, c, ntfull;
    __host__ __device__ void init(int M, int N, int G_, int c_) { nM = M / BM; nN = N / BM; nwg = nM * nN; G = G_; c = c_; ntfull = 0; }
    __host__ __device__ bool next(int i, Unit& u) const {
        const long L = (long)i * G + c; if (L >= nwg) return false;
        int wgid = (int)L; { const int q = nwg / NXCD, r = nwg % NXCD, xcd = wgid % NXCD, off = wgid / NXCD; wgid = (xcd < r ? xcd * (q + 1) : r * (q + 1) + (xcd - r) * q) + off; }
        const int nig = WGM * nN, gid = wgid / nig, fm = gid * WGM, gsz = (nM - fm) < WGM ? (nM - fm) : WGM;
        u.pm = fm + ((wgid % nig) % gsz); u.pn = (wgid % nig) / gsz; u.k0t = 0; u.nt = ntfull; u.part = 0; return true;
    }
    __device__ __forceinline__ void a_ready(const Unit&) const {}
    __device__ __forceinline__ void done(const Unit&) const {}
};
__device__ __forceinline__ unsigned cvt_pk_bf16(float lo, float hi) { unsigned r; asm volatile("v_cvt_pk_bf16_f32 %0, %1, %2" : "=v"(r) : "v"(lo), "v"(hi)); return r; }
template <class Epi, class Sched, bool STAMP = false>
__device__ __forceinline__ void gemm_phase(PG8_LAS unsigned char* lds, const Gemm g, const Sched& S, const Epi& E, unsigned long long* stamps) {
    int tid_ = threadIdx.x; asm volatile("" : "+v"(tid_));
    const int tid = tid_, wid = __builtin_amdgcn_readfirstlane(tid >> 6), lane = tid & 63, wr = wid >> 2, wc = wid & 3, fr = lane & 15, fq = lane >> 4;
    const int K = g.K;
    int ts_lo = 0, ts_hi = 0, nts = 0; const unsigned long long rt_entry = STAMP ? (unsigned long long)wall_clock64() : 0ull;
#define PG8_STAMP() do { if (STAMP && wid == 0 && nts < 64) { const unsigned long long _c = (unsigned long long)clock64(); \
        ts_lo = (lane == nts) ? (int)(unsigned)_c : ts_lo; ts_hi = (lane == nts) ? (int)(unsigned)(_c >> 32) : ts_hi; ++nts; } } while (0)
    PG8_STAMP();
    unsigned voffA[2], voffB[2];
#pragma unroll
    for (int i = 0; i < 2; ++i) { int R, C; stage_rc(tid * 16 + i * 8192, R, C); const int Rb = Epi::PERM ? ((R & ~31) + perm32(R & 31)) : R;
        voffA[i] = (unsigned)(R * K + C) * 2u; voffB[i] = (unsigned)(Rb * K + C) * 2u; }
    const size_t kstep = (size_t)(BK * 2);
    const size_t hstep = (size_t)HALF * K * 2;
    const size_t tstep = 2 * hstep;
    const unsigned ldsw = (unsigned)wid * 1024u;
    const int aoff = lds_byte(wr * 64 + fr, fq * 8), boff = lds_byte(wc * 32 + fr, fq * 8);
#define PG8_SA(b, h) (((b) * 2 + (h)) * HTB)
#define PG8_SB(b, h) ((4 + (b) * 2 + (h)) * HTB)
#define PG8_STAGE(bufoff, gbase, voff) do { _Pragma("unroll") for (int _i = 0; _i < 2; ++_i) \
        __builtin_amdgcn_global_load_lds((const unsigned*)((const char*)(gbase) + (voff)[_i]), (PG8_LAS unsigned*)(lds + (bufoff) + ldsw + _i * 8192), 16, 0, 0); } while (0)
#define PG8_LDA(dst, b, h) do { _Pragma("unroll") for (int m = 0; m < 4; ++m) _Pragma("unroll") for (int k = 0; k < 2; ++k) dst[m][k] = *(const PG8_LAS bf16x8*)(lds + PG8_SA(b, h) + aoff + m * 2048 + k * 1024); } while (0)
#define PG8_LDB(dst, b, h) do { _Pragma("unroll") for (int n = 0; n < 2; ++n) _Pragma("unroll") for (int k = 0; k < 2; ++k) dst[n][k] = *(const PG8_LAS bf16x8*)(lds + PG8_SB(b, h) + boff + n * 2048 + k * 1024); } while (0)
#define PG8_MMA(ai, bj, At, Bt) do { __builtin_amdgcn_s_setprio(1); _Pragma("unroll") for (int m = 0; m < 4; ++m) _Pragma("unroll") for (int n = 0; n < 2; ++n) _Pragma("unroll") for (int k = 0; k < 2; ++k) \
        acc[ai][bj][m][n] = __builtin_amdgcn_mfma_f32_16x16x32_bf16(Bt[n][k], At[m][k], acc[ai][bj][m][n], 0, 0, 0); __builtin_amdgcn_s_setprio(0); } while (0)
#define PG8_WAIT_V(n) asm volatile("s_waitcnt vmcnt(" #n ")" ::: "memory")
#define PG8_WAIT_L(n) asm volatile("s_waitcnt lgkmcnt(" #n ")" ::: "memory")
#define PG8_BAR __builtin_amdgcn_s_barrier()
#define PG8_SCHED __builtin_amdgcn_sched_barrier(0)
    Unit cur, nxt; int ui = 0;
    if (!S.next(0, cur)) return;
    f32x4 acc[2][2][4][2];
#pragma unroll
    for (int a = 0; a < 2; ++a)
#pragma unroll
        for (int b = 0; b < 2; ++b)
#pragma unroll
            for (int m = 0; m < 4; ++m)
#pragma unroll
                for (int n = 0; n < 2; ++n) acc[a][b][m][n] = (f32x4){0.f, 0.f, 0.f, 0.f};
    bf16x8 At[4][2], B0[2][2], B1[2][2];
    const char* cA = (const char*)g.A + (size_t)cur.pm * tstep + (size_t)cur.k0t * kstep; const char* cB = (const char*)g.Bt + (size_t)cur.pn * tstep + (size_t)cur.k0t * kstep;
    S.a_ready(cur);
    PG8_STAGE(PG8_SB(0, 0), cB, voffB); PG8_STAGE(PG8_SA(0, 0), cA, voffA); PG8_STAGE(PG8_SB(0, 1), cB + hstep, voffB); PG8_STAGE(PG8_SA(0, 1), cA + hstep, voffA);
    if (wr == 1) PG8_BAR;
    PG8_WAIT_V(4); PG8_BAR;
    PG8_STAGE(PG8_SB(1, 0), cB + kstep, voffB); PG8_STAGE(PG8_SA(1, 0), cA + kstep, voffA); PG8_STAGE(PG8_SB(1, 1), cB + hstep + kstep, voffB);
    PG8_WAIT_V(6); PG8_BAR;
    PG8_STAMP();
    for (;;) {
        const bool has_next = S.next(ui + 1, nxt);
        const char* nA = has_next ? (const char*)g.A + (size_t)nxt.pm * tstep + (size_t)nxt.k0t * kstep : cA; const char* nB = has_next ? (const char*)g.Bt + (size_t)nxt.pn * tstep + (size_t)nxt.k0t * kstep : cB;
        const int nt = cur.nt;
        for (int t = 0; t < nt; t += 2) {
            const bool last = (t == nt - 2);
            const char* a1 = cA + (size_t)(t + 1) * kstep;
            const char* a2 = last ? nA : cA + (size_t)(t + 2) * kstep; const char* b2 = last ? nB : cB + (size_t)(t + 2) * kstep;
            const char* a3 = a2 + kstep; const char* b3 = b2 + kstep;
            if (last && has_next) S.a_ready(nxt);
            PG8_LDB(B0, 0, 0); PG8_SCHED; PG8_LDA(At, 0, 0); PG8_STAGE(PG8_SA(1, 1), a1 + hstep, voffA);
            PG8_WAIT_L(8); PG8_BAR; PG8_WAIT_L(0); PG8_MMA(0, 0, At, B0); PG8_BAR; PG8_SCHED;
            PG8_LDB(B1, 0, 1); PG8_STAGE(PG8_SB(0, 0), b2, voffB);
            PG8_BAR; PG8_WAIT_L(0); PG8_MMA(0, 1, At, B1); PG8_BAR;
            PG8_LDA(At, 0, 1); PG8_STAGE(PG8_SA(0, 0), a2, voffA);
            PG8_BAR; PG8_WAIT_L(0); PG8_MMA(1, 0, At, B0); PG8_BAR; PG8_SCHED;
            PG8_STAGE(PG8_SB(0, 1), b2 + hstep, voffB);
            PG8_WAIT_V(6); PG8_BAR; PG8_MMA(1, 1, At, B1); PG8_BAR;
            PG8_LDB(B0, 1, 0); PG8_SCHED; PG8_LDA(At, 1, 0); PG8_STAGE(PG8_SA(0, 1), a2 + hstep, voffA);
            PG8_WAIT_L(8); PG8_BAR; PG8_WAIT_L(0); PG8_MMA(0, 0, At, B0); PG8_BAR; PG8_SCHED;
            PG8_LDB(B1, 1, 1); PG8_STAGE(PG8_SB(1, 0), b3, voffB);
            PG8_BAR; PG8_WAIT_L(0); PG8_MMA(0, 1, At, B1); PG8_BAR;
            PG8_LDA(At, 1, 1); PG8_STAGE(PG8_SA(1, 0), a3, voffA);
            PG8_BAR; PG8_WAIT_L(0); PG8_MMA(1, 0, At, B0); PG8_BAR; PG8_SCHED;
            PG8_STAGE(PG8_SB(1, 1), b3 + hstep, voffB);
            PG8_WAIT_V(6); PG8_BAR; PG8_MMA(1, 1, At, B1); PG8_BAR;
        }
        PG8_STAMP();
        if constexpr (!Epi::AFTER_DRAIN) { E(acc, cur, wr, wc, fr, fq); S.done(cur); }
        PG8_STAMP();
        if (!has_next) break;
#pragma unroll
        for (int a = 0; a < 2; ++a)
#pragma unroll
            for (int b = 0; b < 2; ++b)
#pragma unroll
                for (int m = 0; m < 4; ++m)
#pragma unroll
                    for (int n = 0; n < 2; ++n) acc[a][b][m][n] = (f32x4){0.f, 0.f, 0.f, 0.f};
        cur = nxt; cA = nA; cB = nB; ++ui;
    }
    PG8_WAIT_V(0);
    if (wr == 0) PG8_BAR;
    PG8_BAR;
    if constexpr (Epi::AFTER_DRAIN) { E.fused(acc, cur, wr, wc, fr, fq, lds, wid, lane); S.done(cur); }
    PG8_STAMP();
    if (STAMP && wid == 0) { stamps[lane] = lane < nts ? (((unsigned long long)(unsigned)ts_hi << 32) | (unsigned)ts_lo) : 0ull;
        if (lane == 62) stamps[62] = rt_entry; if (lane == 63) stamps[63] = (unsigned long long)wall_clock64(); }
#undef PG8_STAMP
#undef PG8_SA
#undef PG8_SB
#undef PG8_STAGE
#undef PG8_LDA
#undef PG8_LDB
#undef PG8_MMA
#undef PG8_WAIT_V
#undef PG8_WAIT_L
#undef PG8_BAR
#undef PG8_SCHED
}
}
#define XB_TMO      128
#define XB_XCNT(j)  (256  + 64 * (j))
#define XB_XSUB(j)  (1280 + 64 * (j))
#define XB_XGEN(j)  (2304 + 64 * (j))
#define XB_TOP      3328
#define XB_TOPGEN   3392
#define XCD_BAR_WORDS 3456
#define XB_SPIN_CAP (1u << 18)
#define LAS __attribute__((address_space(3)))

__device__ __forceinline__ unsigned xb_ld(unsigned* p)              { return __hip_atomic_load(p, __ATOMIC_RELAXED, __HIP_MEMORY_SCOPE_AGENT); }
__device__ __forceinline__ unsigned xb_add(unsigned* p, unsigned v) { return __hip_atomic_fetch_add(p, v, __ATOMIC_RELAXED, __HIP_MEMORY_SCOPE_AGENT); }
__device__ __forceinline__ unsigned xb_xcc_id() { return (unsigned)__builtin_amdgcn_s_getreg((3 << 11) | 20) & 0xFu; }
#define XB_SPIN(cond, bar) do { unsigned _sp = 0; while (cond) { __builtin_amdgcn_s_sleep(1); \
    if ((++_sp & 255u) == 0u) { if (xb_ld(&(bar)[XB_TMO])) break; if (_sp > XB_SPIN_CAP) { atomicAdd(&(bar)[XB_TMO], 1u); break; } } } } while (0)

struct XcdBarrier {
    unsigned* bar; unsigned x;
    volatile LAS unsigned* st;
};

__device__ __forceinline__ XcdBarrier xcd_barrier_post(unsigned* bar, volatile LAS unsigned* st) {
    XcdBarrier b; b.bar = bar; b.x = xb_xcc_id(); b.st = st;
    if (threadIdx.x == 0) (void)xb_add(&bar[XB_XCNT(b.x)], 1u);
    return b;
}
__device__ __forceinline__ void xcd_barrier_complete(unsigned* bar, unsigned x, unsigned& nloc, unsigned& nx) {
    const unsigned G = gridDim.x * gridDim.y * gridDim.z;
    unsigned sum, cnt, mine, sp = 0u;
    for (;;) {
        sum = 0u; cnt = 0u; mine = 0u;
#pragma unroll
        for (unsigned j = 0; j < 16; ++j) { const unsigned c = xb_ld(&bar[XB_XCNT(j)]); sum += c; cnt += (c > 0u) ? 1u : 0u; mine = (j == x) ? c : mine; }
        if (sum == G) break;
        __builtin_amdgcn_s_sleep(1);
        if ((++sp & 255u) == 0u) { if (xb_ld(&bar[XB_TMO])) break; if (sp > XB_SPIN_CAP) { atomicAdd(&bar[XB_TMO], 1u); break; } }
    }
    nloc = mine > 0u ? mine : 1u; nx = cnt > 0u ? cnt : 1u;
}

__device__ __forceinline__ void xcd_barrier(const XcdBarrier& b) {
    asm volatile("s_waitcnt vmcnt(0)" ::: "memory");
    __syncthreads();
    if (threadIdx.x == 0) {
        unsigned* bar = b.bar;
        __builtin_amdgcn_s_waitcnt(0);
        unsigned nloc = b.st[0], nx = b.st[1];
        if (nloc == 0u) { xcd_barrier_complete(bar, b.x, nloc, nx); b.st[0] = nloc; b.st[1] = nx; }
        const unsigned old = xb_add(&bar[XB_XSUB(b.x)], 1u);
        const unsigned gen = old / nloc;
        if (old + 1u == (gen + 1u) * nloc) {
            __builtin_amdgcn_fence(__ATOMIC_RELEASE, "agent");
            asm volatile("s_waitcnt vmcnt(0)" ::: "memory");
            const unsigned og = xb_add(&bar[XB_TOP], 1u);
            const unsigned tg = og / nx;
            if (og + 1u == (tg + 1u) * nx) xb_add(&bar[XB_TOPGEN], 1u);
            else XB_SPIN(xb_ld(&bar[XB_TOPGEN]) == tg, bar);
            __builtin_amdgcn_fence(__ATOMIC_ACQUIRE, "agent");
            xb_add(&bar[XB_XGEN(b.x)], 1u);
            asm volatile("s_waitcnt vmcnt(0)" ::: "memory");
        } else {
            XB_SPIN(xb_ld(&bar[XB_XGEN(b.x)]) == gen, bar);
            __builtin_amdgcn_fence(__ATOMIC_ACQUIRE, "agent");
            asm volatile("s_waitcnt vmcnt(0)" ::: "memory");
        }
    }
    __syncthreads();
}


using pg8::bf16_t; using pg8::bf16x8; using pg8::f32x4; using pg8::Unit;
typedef short bf16x4 __attribute__((ext_vector_type(4)));
typedef unsigned u32x4 __attribute__((ext_vector_type(4)));
typedef unsigned u32x2 __attribute__((ext_vector_type(2)));

constexpr int TP = 16384, TT = 16640, DM = 1024, INW = 1536, DFF = 2816, NGU = 5632;
constexpr int NPT = 512;
constexpr float EPS = 1e-6f;

constexpr size_t SZ_WIN = (size_t)1536 * 1024 * 2, SZ_WOUT = (size_t)1024 * 1024 * 2, SZ_WGU = (size_t)5632 * 1024 * 2, SZ_WDN = (size_t)1024 * 2816 * 2,
                 SZ_WGLU = (size_t)512 * 512 * 2, SZ_WAX = (size_t)2 * 8 * 64 * 64 * 2;
constexpr size_t OFF_WIN = 0;
constexpr size_t OFF_WOUT = OFF_WIN + 2 * SZ_WIN;
constexpr size_t OFF_WGU = OFF_WOUT + 2 * SZ_WOUT;
constexpr size_t OFF_WDN = OFF_WGU + 2 * SZ_WGU;
constexpr size_t OFF_WGLU = OFF_WDN + 2 * SZ_WDN;
constexpr size_t OFF_WAX = OFF_WGLU + 2 * SZ_WGLU;
constexpr size_t OFF_BB = OFF_WAX + 2 * SZ_WAX;
constexpr size_t OFF_CM = OFF_BB + (size_t)2 * 32 * 128 * 16 * 2;
constexpr size_t OFF_LB = OFF_CM + (size_t)2 * 32 * 16 * 128 * 2;
constexpr size_t OFF_SS = OFF_LB + (size_t)2 * 4 * 2048 * 4;
constexpr size_t OFF_LRUA = OFF_SS + (size_t)5 * TT * 4;
constexpr size_t OFF_LRUB = OFF_LRUA + (size_t)NPT * 512 * 4;
constexpr size_t OFF_LRUC = OFF_LRUB + (size_t)NPT * 512 * 4;
constexpr size_t OFF_S5E = OFF_LRUC + (size_t)NPT * 512 * 4;
constexpr size_t OFF_S5C = OFF_S5E + (size_t)NPT * 2 * 2048 * 4;
constexpr size_t OFF_XB = OFF_S5C + (size_t)NPT * 2 * 2048 * 4;
constexpr size_t OFF_R = OFF_XB + (size_t)TT * 1024 * 2;
constexpr size_t OFF_Z = OFF_R, OFF_MIX = OFF_R + (size_t)TT * 1536 * 2, OFF_FF = OFF_R;
constexpr size_t OFF_BAR = OFF_R + (size_t)TT * 2816 * 2;
constexpr size_t OFF_PART = OFF_BAR + 16384;
constexpr size_t OFF_HL = OFF_PART + (size_t)11 * 256 * 1024 * 4;
constexpr size_t OFF_PL = OFF_HL + (size_t)TP * 512 * 2;
constexpr size_t WS_END = OFF_PL + (size_t)TP * 512 * 2;

constexpr size_t O_Y = 0, O_CONV_P = (size_t)TT * 1024, O_LRU_P = O_CONV_P + 3072, O_RE_P = O_LRU_P + 1024, O_IM_P = O_RE_P + 4096,
                 O_CONV_S = O_IM_P + 4096, O_LRU_S = O_CONV_S + 24576, O_RE_S = O_LRU_S + 8192, O_IM_S = O_RE_S + 32768;

constexpr int LDS_GT = 32 * 520 * 2;
constexpr int LDS_RA = 10240;
constexpr int LDS_WSC = LDS_RA + 4352;
constexpr int LDS_BYTES = 150528;
constexpr int LDS_XB = LDS_BYTES - 16;

struct Params { const float* in[33]; float* out; unsigned char* ws; };

__device__ __forceinline__ unsigned pk_bf16(float lo, float hi) { unsigned r; asm("v_cvt_pk_bf16_f32 %0, %1, %2" : "=v"(r) : "v"(lo), "v"(hi)); return r; }
__device__ __forceinline__ bf16_t f2bf(float f) { return (bf16_t)pk_bf16(f, f); }
__device__ __forceinline__ float bf2f(bf16_t b) { return __uint_as_float(((unsigned)b) << 16); }
__device__ __forceinline__ float sigm(float x) { return __builtin_amdgcn_rcpf(1.f + __expf(-x)); }
__device__ __forceinline__ float gelu_t(float x) { return x * sigm(1.5957691216057308f * (x + 0.044715f * x * x * x)); }
__device__ __forceinline__ int opaque_tid() { int t = threadIdx.x; asm volatile("" : "+v"(t)); return t; }
#define WAVE_SYNC() do { __builtin_amdgcn_fence(__ATOMIC_RELEASE, "wavefront"); __builtin_amdgcn_wave_barrier(); __builtin_amdgcn_fence(__ATOMIC_ACQUIRE, "wavefront"); } while (0)

struct EpiZ {
    static constexpr bool PERM = true, AFTER_DRAIN = false;
    bf16_t* O; const float* ss;
    __device__ __forceinline__ void operator()(const f32x4 (&acc)[2][2][4][2], const Unit& u, int wr, int wc, int fr, int fq) const {
        const int row0 = u.pm * 256 + wr * 64 + fr, col0 = u.pn * 256 + wc * 32 + 8 * fq;
        float rs[2][4];
#pragma unroll
        for (int ai = 0; ai < 2; ++ai)
#pragma unroll
            for (int m = 0; m < 4; ++m) rs[ai][m] = ss[row0 + ai * 128 + m * 16];
#pragma unroll
        for (int ai = 0; ai < 2; ++ai)
#pragma unroll
            for (int m = 0; m < 4; ++m) {
                const int row = row0 + ai * 128 + m * 16; const float r1 = rsqrtf(rs[ai][m] * (1.f / 1024.f) + EPS);
                bf16_t* rp = O + (size_t)row * INW + col0;
#pragma unroll
                for (int bj = 0; bj < 2; ++bj) { const f32x4 v0 = acc[ai][bj][m][0] * r1, v1 = acc[ai][bj][m][1] * r1;
                    u32x4 pk; pk[0] = pk_bf16(v0[0], v0[1]); pk[1] = pk_bf16(v0[2], v0[3]); pk[2] = pk_bf16(v1[0], v1[1]); pk[3] = pk_bf16(v1[2], v1[3]);
                    *(u32x4*)(rp + bj * 128) = pk; }
            }
    }
};
struct EpiFF {
    static constexpr bool PERM = true, AFTER_DRAIN = false;
    bf16_t* O; const float* ss;
    __device__ __forceinline__ void operator()(const f32x4 (&acc)[2][2][4][2], const Unit& u, int wr, int wc, int fr, int fq) const {
        const int row0 = u.pm * 256 + wr * 64 + fr, f0 = u.pn * 128 + wc * 32 + 8 * fq;
        float rs[2][4];
#pragma unroll
        for (int ai = 0; ai < 2; ++ai)
#pragma unroll
            for (int m = 0; m < 4; ++m) rs[ai][m] = ss[row0 + ai * 128 + m * 16];
#pragma unroll
        for (int ai = 0; ai < 2; ++ai)
#pragma unroll
            for (int m = 0; m < 4; ++m) {
                const int row = row0 + ai * 128 + m * 16; const float r1 = rsqrtf(rs[ai][m] * (1.f / 1024.f) + EPS), r2 = r1 * -1.4426950408889634f;
                float o[8];
#pragma unroll
                for (int n = 0; n < 2; ++n)
#pragma unroll
                    for (int i = 0; i < 4; ++i) { const float ag = acc[ai][0][m][n][i];
                        o[n * 4 + i] = (ag * r1) * (acc[ai][1][m][n][i] * r1) * __builtin_amdgcn_rcpf(1.f + __builtin_amdgcn_exp2f(ag * r2)); }
                u32x4 pk; pk[0] = pk_bf16(o[0], o[1]); pk[1] = pk_bf16(o[2], o[3]); pk[2] = pk_bf16(o[4], o[5]); pk[3] = pk_bf16(o[6], o[7]);
                *(u32x4*)(O + (size_t)row * DFF + f0) = pk;
            }
    }
};
struct EpiRes {
    static constexpr bool PERM = true, AFTER_DRAIN = false;
    bf16_t* xb; float* ss; float* part;
    __device__ __forceinline__ void operator()(const f32x4 (&acc)[2][2][4][2], const Unit& u, int wr, int wc, int fr, int fq) const {
        const int row0 = u.pm * 256 + wr * 64 + fr, col0 = u.pn * 256 + wc * 32 + 8 * fq;
        if (u.part) {
            float* pb = part + ((size_t)(u.k0t / u.nt) * 256 + (wr * 64 + fr)) * 1024 + col0;
#pragma unroll
            for (int ai = 0; ai < 2; ++ai)
#pragma unroll
                for (int m = 0; m < 4; ++m) { float* op = pb + (size_t)(ai * 128 + m * 16) * 1024;
#pragma unroll
                    for (int bj = 0; bj < 2; ++bj)
#pragma unroll
                        for (int n = 0; n < 2; ++n) *(f32x4*)(op + bj * 128 + 4 * n) = acc[ai][bj][m][n]; }
            return;
        }
#pragma unroll
        for (int ai = 0; ai < 2; ++ai) {
            u32x4 xv[4][2];
#pragma unroll
            for (int m = 0; m < 4; ++m)
#pragma unroll
                for (int bj = 0; bj < 2; ++bj) xv[m][bj] = *(const u32x4*)(xb + (size_t)(row0 + ai * 128 + m * 16) * 1024 + col0 + bj * 128);
#pragma unroll
            for (int m = 0; m < 4; ++m) {
                const int row = row0 + ai * 128 + m * 16; bf16_t* bp = xb + (size_t)row * 1024 + col0; float sq = 0.f;
#pragma unroll
                for (int bj = 0; bj < 2; ++bj) { const u32x4 w = xv[m][bj]; u32x4 pk;
#pragma unroll
                    for (int n = 0; n < 2; ++n) { const f32x4 a = acc[ai][bj][m][n];
                        const float v0 = __uint_as_float(w[2 * n] << 16) + a[0], v1 = __uint_as_float(w[2 * n] & 0xFFFF0000u) + a[1], v2 = __uint_as_float(w[2 * n + 1] << 16) + a[2], v3 = __uint_as_float(w[2 * n + 1] & 0xFFFF0000u) + a[3];
                        pk[2 * n] = pk_bf16(v0, v1); pk[2 * n + 1] = pk_bf16(v2, v3); sq += v0 * v0 + v1 * v1 + v2 * v2 + v3 * v3; }
                    *(u32x4*)(bp + bj * 128) = pk; }
                sq += __shfl_xor(sq, 16); sq += __shfl_xor(sq, 32);
                if (fq == 0) atomicAdd(ss + row, sq);
            }
        }
    }
};
struct SplitOrder : pg8::StaticOrder {
    int nwgP, nsplit, ntS, nNs;
    __device__ __forceinline__ void init2(int N, int K, int G_, int c_, int nsplit_) { init(TP, N, G_, c_); ntfull = K / 64; nwgP = nwg; nNs = N / 256; nsplit = nsplit_; ntS = ntfull / nsplit_; }
    __device__ __forceinline__ bool next(int i, Unit& u) const {
        const long L = (long)i * G + c;
        if (L < nwgP) return pg8::StaticOrder::next(i, u);
        const int sidx = (int)(L - nwgP); if (sidx >= nNs * nsplit) return false;
        u.pm = 64; u.pn = sidx % nNs; u.k0t = (sidx / nNs) * ntS; u.nt = ntS; u.part = 1; return true;
    }
};
__device__ __forceinline__ void sample_fix(const Params& P, int nsplit, float* ss_out, unsigned* ctr, int first_wg) {
    const int tid = opaque_tid(), wid = tid >> 6, lane = tid & 63; const float* part = (const float*)(P.ws + OFF_PART);
    if ((int)gridDim.x < first_wg + 32) first_wg = 0;
    for (int r = ((int)blockIdx.x - first_wg) * 8 + wid; r >= 0 && r < 256; r += 256) { const int row = TP + r; bf16_t* xb = (bf16_t*)(P.ws + OFF_XB) + (size_t)row * 1024; float sq = 0.f;
        float4 v[4];
#pragma unroll
        for (int j = 0; j < 4; ++j) { const u32x2 w = *(const u32x2*)(xb + j * 256 + lane * 4); v[j].x = __uint_as_float(w[0] << 16); v[j].y = __uint_as_float(w[0] & 0xFFFF0000u); v[j].z = __uint_as_float(w[1] << 16); v[j].w = __uint_as_float(w[1] & 0xFFFF0000u); }
        for (int s0 = 0; s0 < nsplit; s0 += 4) {
            float4 w[4][4];
#pragma unroll
            for (int b = 0; b < 4; ++b) if (s0 + b < nsplit) { const float* pr = part + ((size_t)(s0 + b) * 256 + r) * 1024;
#pragma unroll
                for (int j = 0; j < 4; ++j) w[b][j] = *(const float4*)(pr + j * 256 + lane * 4); }
#pragma unroll
            for (int b = 0; b < 4; ++b) if (s0 + b < nsplit) {
#pragma unroll
                for (int j = 0; j < 4; ++j) { v[j].x += w[b][j].x; v[j].y += w[b][j].y; v[j].z += w[b][j].z; v[j].w += w[b][j].w; } } }
#pragma unroll
        for (int j = 0; j < 4; ++j) { sq += v[j].x * v[j].x + v[j].y * v[j].y + v[j].z * v[j].z + v[j].w * v[j].w;
            u32x2 pk; pk[0] = pk_bf16(v[j].x, v[j].y); pk[1] = pk_bf16(v[j].z, v[j].w); *(u32x2*)(xb + j * 256 + lane * 4) = pk; }
#pragma unroll
        for (int o = 1; o < 64; o <<= 1) sq += __shfl_xor(sq, o);
        if (lane == 0) ss_out[row] = sq;
        __builtin_amdgcn_fence(__ATOMIC_RELEASE, "agent");
        asm volatile("s_waitcnt vmcnt(0)" ::: "memory");
        if (lane == 0) __hip_atomic_fetch_add(ctr, 1u, __ATOMIC_RELAXED, __HIP_MEMORY_SCOPE_AGENT); }
}
constexpr int CTR_WORD0 = 3584;
struct WaitOrder : pg8::StaticOrder {
    const unsigned* ready;
    __device__ __forceinline__ void a_ready(const Unit& u) const {
        if (ready == nullptr || u.pm != 64) return;
        if (threadIdx.x < 64) {
            unsigned polls = 0;
            while ((unsigned)__builtin_amdgcn_readfirstlane((int)__hip_atomic_load(ready, __ATOMIC_RELAXED, __HIP_MEMORY_SCOPE_AGENT)) < 256u) { if (++polls > (1u << 22)) break; __builtin_amdgcn_s_sleep(2); }
            __builtin_amdgcn_fence(__ATOMIC_ACQUIRE, "agent");
            asm volatile("s_waitcnt vmcnt(0)" ::: "memory");
        }
        asm volatile("" ::: "memory"); __builtin_amdgcn_s_barrier(); asm volatile("" ::: "memory");
    }
};
template <class Epi> __device__ __forceinline__ void run_gemm(unsigned char* lds, const bf16_t* A, const bf16_t* Bt, int M, int N, int K, const Epi& E, const unsigned* ready) {
    pg8::Gemm g{A, Bt, M, N, K}; WaitOrder S; S.init(M, N, (int)gridDim.x, (int)blockIdx.x); S.ntfull = K / 64; S.ready = ready;
    pg8::gemm_phase<Epi, WaitOrder, false>((PG8_LAS unsigned char*)lds, g, S, E, nullptr);
}
struct SampleFirstOrder : pg8::StaticOrder {
    const unsigned* ready; unsigned* donectr; int nNs;
    __device__ __forceinline__ void init3(int N, int K, int G_, int c_) { init(TP, N, G_, c_); ntfull = K / 64; nNs = N / 256; }
    __device__ __forceinline__ bool next(int i, Unit& u) const {
        long L = (long)i * G + c; u.k0t = 0; u.nt = ntfull; u.part = 0;
        if (L < nNs) { u.pm = 64; u.pn = (int)L; return true; }
        L -= nNs; if (L >= nwg) return false;
        int wgid = (int)L; { const int q = nwg / pg8::NXCD, r = nwg % pg8::NXCD, xcd = wgid % pg8::NXCD, off = wgid / pg8::NXCD; wgid = (xcd < r ? xcd * (q + 1) : r * (q + 1) + (xcd - r) * q) + off; }
        const int nig = pg8::WGM * nN, gid = wgid / nig, fm = gid * pg8::WGM, gsz = (nM - fm) < pg8::WGM ? (nM - fm) : pg8::WGM;
        u.pm = fm + ((wgid % nig) % gsz); u.pn = (wgid % nig) / gsz; return true;
    }
    __device__ __forceinline__ void a_ready(const Unit& u) const {
        if (ready == nullptr || u.pm != 64) return;
        if (threadIdx.x < 64) {
            unsigned polls = 0;
            while ((unsigned)__builtin_amdgcn_readfirstlane((int)__hip_atomic_load(ready, __ATOMIC_RELAXED, __HIP_MEMORY_SCOPE_AGENT)) < 256u) { if (++polls > (1u << 22)) break; __builtin_amdgcn_s_sleep(2); }
            __builtin_amdgcn_fence(__ATOMIC_ACQUIRE, "agent");
            asm volatile("s_waitcnt vmcnt(0)" ::: "memory");
        }
        asm volatile("" ::: "memory"); __builtin_amdgcn_s_barrier(); asm volatile("" ::: "memory");
    }
    __device__ __forceinline__ void done(const Unit& u) const {
        if (u.pm != 64 || donectr == nullptr) return;
        __builtin_amdgcn_fence(__ATOMIC_RELEASE, "agent"); asm volatile("s_waitcnt vmcnt(0)" ::: "memory");
        if ((threadIdx.x & 63) == 0) __hip_atomic_fetch_add(donectr, 1u, __ATOMIC_RELAXED, __HIP_MEMORY_SCOPE_AGENT);
    }
};
template <class Epi> __device__ __forceinline__ void run_gemm_g1(unsigned char* lds, const bf16_t* A, const bf16_t* Bt, int N, int K, const Epi& E, const unsigned* ready, unsigned* donectr) {
    pg8::Gemm g{A, Bt, TT, N, K}; SampleFirstOrder S; S.init3(N, K, (int)gridDim.x, (int)blockIdx.x); S.ready = ready; S.donectr = donectr;
    pg8::gemm_phase<Epi, SampleFirstOrder, false>((PG8_LAS unsigned char*)lds, g, S, E, nullptr);
}
template <class Epi> __device__ __forceinline__ void run_gemm_sample_split(unsigned char* lds, const bf16_t* A, const bf16_t* Bt, int N, int K, int nsplit, int rank, const Epi& E) {
    pg8::Gemm g{A, Bt, TT, N, K}; SplitOrder S; S.init2(N, K, 1 << 20, rank, nsplit); S.nwgP = 0;
    pg8::gemm_phase<Epi, SplitOrder, false>((PG8_LAS unsigned char*)lds, g, S, E, nullptr);
}
__device__ __forceinline__ void wait_counter(const unsigned* ctr, unsigned need) {
    if (threadIdx.x < 64) {
        unsigned polls = 0;
        while ((unsigned)__builtin_amdgcn_readfirstlane((int)__hip_atomic_load(ctr, __ATOMIC_RELAXED, __HIP_MEMORY_SCOPE_AGENT)) < need) { if (++polls > (1u << 22)) break; __builtin_amdgcn_s_sleep(2); }
        __builtin_amdgcn_fence(__ATOMIC_ACQUIRE, "agent");
        asm volatile("s_waitcnt vmcnt(0)" ::: "memory");
    }
    __syncthreads();
}
template <class Epi> __device__ __forceinline__ void run_gemm_split(unsigned char* lds, const bf16_t* A, const bf16_t* Bt, int N, int K, int nsplit, const Epi& E) {
    pg8::Gemm g{A, Bt, TT, N, K}; SplitOrder S; S.init2(N, K, (int)gridDim.x, (int)blockIdx.x, nsplit);
    pg8::gemm_phase<Epi, SplitOrder, false>((PG8_LAS unsigned char*)lds, g, S, E, nullptr);
}

struct TrTile { const float* src; const float* gain; bf16_t* dst; int N, K, k0, n0, drow; };
__device__ __forceinline__ TrTile tr_decode(const Params& P, int it) {
    unsigned char* ws = P.ws; TrTile t; const int l = it / 2816; int i = it % 2816; int kt, nt;
    if (i < 384) { kt = i / 24; nt = i % 24; t.src = P.in[7] + (size_t)l * 1024 * 1536; t.N = 1536; t.K = 1024; t.gain = P.in[6] + l * 1024 + kt * 64; t.dst = (bf16_t*)(ws + OFF_WIN + l * SZ_WIN); t.drow = nt * 64; }
    else if (i < 640) { i -= 384; kt = i / 16; nt = i % 16; t.src = P.in[27] + (size_t)l * 1024 * 1024; t.N = 1024; t.K = 1024;
        t.gain = kt < 8 ? P.in[25] + l * 512 + kt * 64 : P.in[26] + l * 512 + (kt - 8) * 64; t.dst = (bf16_t*)(ws + OFF_WOUT + l * SZ_WOUT); t.drow = nt * 64; }
    else if (i < 2048) { const bool up = i >= 1344; i -= up ? 1344 : 640; kt = i / 44; nt = i % 44; t.src = (up ? P.in[30] : P.in[29]) + (size_t)l * 1024 * 2816; t.N = 2816; t.K = 1024;
        t.gain = P.in[28] + l * 1024 + kt * 64; t.dst = (bf16_t*)(ws + OFF_WGU + l * SZ_WGU); const int f0 = nt * 64; t.drow = (f0 >> 7) * 256 + (f0 & 127) + (up ? 128 : 0); }
    else if (i < 2752) { i -= 2048; kt = i / 16; nt = i % 16; t.src = P.in[31] + (size_t)l * 2816 * 1024; t.N = 1024; t.K = 2816; t.gain = nullptr; t.dst = (bf16_t*)(ws + OFF_WDN + l * SZ_WDN); t.drow = nt * 64; }
    else { i -= 2752; kt = i / 8; nt = i % 8; t.src = P.in[23] + (size_t)l * 512 * 512; t.N = 512; t.K = 512; t.gain = nullptr; t.dst = (bf16_t*)(ws + OFF_WGLU + l * SZ_WGLU); t.drow = nt * 64; }
    t.k0 = kt * 64; t.n0 = nt * 64; return t;
}

__device__ __forceinline__ void convert_range(const Params& P, int count, int base, int split_at, int jump, int rank, int nblk, unsigned char* lds) {
    float* tile = (float*)lds; const int tid = opaque_tid();
    __syncthreads();
    for (int v0 = rank * 4; v0 < count; v0 += nblk * 4) {
        float4 v[4][2]; float gn[4][2];
#pragma unroll
        for (int j = 0; j < 4; ++j) if (v0 + j < count) { const int vv = v0 + j; const TrTile t = tr_decode(P, base + (vv < split_at ? vv : vv + jump));
#pragma unroll
            for (int i = 0; i < 2; ++i) { const int kk = (tid >> 4) + i * 32, nq = tid & 15; v[j][i] = *(const float4*)(t.src + (size_t)(t.k0 + kk) * t.N + t.n0 + nq * 4); gn[j][i] = t.gain ? t.gain[kk] : 1.f; } }
        __syncthreads();
#pragma unroll
        for (int j = 0; j < 4; ++j) if (v0 + j < count) {
#pragma unroll
            for (int i = 0; i < 2; ++i) { const int kk = (tid >> 4) + i * 32, nq = tid & 15; float* tp = tile + j * 4160 + kk * 65 + nq * 4; const float g = gn[j][i];
                tp[0] = v[j][i].x * g; tp[1] = v[j][i].y * g; tp[2] = v[j][i].z * g; tp[3] = v[j][i].w * g; } }
        __syncthreads();
#pragma unroll
        for (int j = 0; j < 4; ++j) if (v0 + j < count) { const int vv = v0 + j; const TrTile t = tr_decode(P, base + (vv < split_at ? vv : vv + jump)); const int n = tid >> 3, kq = tid & 7; const float* tp = tile + j * 4160 + (kq * 8) * 65 + n;
            u32x4 pk; pk[0] = pk_bf16(tp[0], tp[65]); pk[1] = pk_bf16(tp[130], tp[195]); pk[2] = pk_bf16(tp[260], tp[325]); pk[3] = pk_bf16(tp[390], tp[455]);
            *(u32x4*)(t.dst + (size_t)(t.drow + n) * t.K + t.k0 + kq * 8) = pk; }
    }
    __syncthreads();
}
__device__ __forceinline__ void convert_by_idle(const Params& P, int items, int count, int base, int split_at, int jump, unsigned char* lds) {
    const int G = (int)gridDim.x, c = (int)blockIdx.x; const int first = items < G ? items : items % G;
    if (first == 0 || first >= G) convert_range(P, count, base, split_at, jump, c, G, lds);
    else if (c >= first) convert_range(P, count, base, split_at, jump, c - first, G - first, lds);
}

__device__ __forceinline__ void prep_phase(const Params& P, unsigned char* lds) {
    float* tile = (float*)lds; unsigned char* ws = P.ws;
    const int tid = opaque_tid(), wid = tid >> 6, lane = tid & 63;
    const int gtid = blockIdx.x * 512 + tid, gsz = gridDim.x * 512;
    for (int row0 = blockIdx.x * 8 + wid; row0 < TT; row0 += gridDim.x * 8 * 4) {
        float4 v[4][4];
#pragma unroll
        for (int q = 0; q < 4; ++q) { const int row = row0 + q * gridDim.x * 8; if (row < TT) { const float* xr = row < TP ? P.in[0] + (size_t)row * 1024 : P.in[1] + (size_t)(row - TP) * 1024;
#pragma unroll
            for (int j = 0; j < 4; ++j) v[q][j] = *(const float4*)(xr + j * 256 + lane * 4); } }
#pragma unroll
        for (int q = 0; q < 4; ++q) { const int row = row0 + q * gridDim.x * 8; if (row < TT) { bf16_t* xb = (bf16_t*)(ws + OFF_XB) + (size_t)row * 1024; float s = 0.f;
#pragma unroll
            for (int j = 0; j < 4; ++j) { const float4 w = v[q][j]; s += w.x * w.x + w.y * w.y + w.z * w.z + w.w * w.w;
                u32x2 pk; pk[0] = pk_bf16(w.x, w.y); pk[1] = pk_bf16(w.z, w.w); *(u32x2*)(xb + j * 256 + lane * 4) = pk; }
#pragma unroll
            for (int o = 1; o < 64; o <<= 1) s += __shfl_xor(s, o);
            if (lane == 0) ((float*)(ws + OFF_SS))[row] = s; } }
    }
    for (int i = gtid; i < 4 * TT; i += gsz) ((float*)(ws + OFF_SS))[TT + i] = 0.f;
    for (int i = gtid; i < 2 * 2 * 8 * 4096; i += gsz) { const int e = i & 4095, hh = (i >> 12) & 7, which = (i >> 15) & 1, l = i >> 16, j = e >> 6, ii = e & 63;
        const float* w = which ? P.in[12] : P.in[10]; ((bf16_t*)(ws + OFF_WAX))[i] = f2bf(w[((size_t)(l * 8 + hh) * 64 + ii) * 64 + j]); }
    for (int i = gtid; i < 4096 * 16; i += gsz) { const int h = i & 15, lgp = i >> 4, l = lgp >> 11, gp = lgp & 2047, g = gp >> 6, p = gp & 63;
        const float lr = P.in[15][lgp], li = P.in[16][lgp], dt = expf(P.in[22][l * 32 + g]);
        const float mag = expf(lr * dt), lbr = mag * cosf(li * dt), lbi = mag * sinf(li * dt);
        const float nr = lbr - 1.f, ni = lbi, den = lr * lr + li * li, gr = (nr * lr + ni * li) / den, gi = (ni * lr - nr * li) / den;
        const float br = P.in[17][(size_t)lgp * 16 + h], bi = P.in[18][(size_t)lgp * 16 + h];
        bf16_t* bb = (bf16_t*)(ws + OFF_BB) + ((size_t)(l * 32 + g) * 128) * 16;
        bb[(size_t)p * 16 + h] = f2bf(gr * br - gi * bi); bb[(size_t)(64 + p) * 16 + h] = f2bf(gr * bi + gi * br);
        bf16_t* cm = (bf16_t*)(ws + OFF_CM) + ((size_t)(l * 32 + g) * 16) * 128;
        cm[h * 128 + 2 * p] = f2bf(P.in[19][((size_t)(l * 32 + g) * 16 + h) * 64 + p]); cm[h * 128 + 2 * p + 1] = f2bf(-P.in[20][((size_t)(l * 32 + g) * 16 + h) * 64 + p]);
        if (h == 0) { float pr = lbr, pi = lbi;
            for (int sq = 0; sq < 5; ++sq) { const float t = pr * pr - pi * pi; pi = 2.f * pr * pi; pr = t; }
            float* lb = (float*)(ws + OFF_LB) + (size_t)l * 4 * 2048; lb[gp] = lbr; lb[2048 + gp] = lbi; lb[4096 + gp] = pr; lb[6144 + gp] = pi; } }
    { const int coff = (int)gridDim.x >= 256 ? 144 : 0;
      if ((int)blockIdx.x >= coff) convert_range(P, 448, 0, 384, 2368, (int)blockIdx.x - coff, (int)gridDim.x - coff, lds); }
}

__device__ __forceinline__ void norm_store(const bf16_t* gtile, bf16_t* dst) {
    const int tid = opaque_tid(), tok = tid >> 4, part = tid & 15; const bf16_t* src = gtile + tok * 520 + part * 32;
    float v[32]; float s = 0.f;
#pragma unroll
    for (int q = 0; q < 4; ++q) { const u32x4 w = *(const u32x4*)(src + q * 8);
#pragma unroll
        for (int e = 0; e < 4; ++e) { const float a = __uint_as_float(w[e] << 16), b = __uint_as_float(w[e] & 0xFFFF0000u); v[q * 8 + e * 2] = a; v[q * 8 + e * 2 + 1] = b; s += a * a + b * b; } }
    s += __shfl_xor(s, 1); s += __shfl_xor(s, 2); s += __shfl_xor(s, 4); s += __shfl_xor(s, 8);
    const float rs = rsqrtf(s * (1.f / 512.f) + EPS);
    bf16_t* d = dst + (size_t)tok * 1024 + part * 32;
#pragma unroll
    for (int q = 0; q < 4; ++q) { u32x4 pk;
#pragma unroll
        for (int e = 0; e < 4; ++e) pk[e] = pk_bf16(v[q * 8 + e * 2] * rs, v[q * 8 + e * 2 + 1] * rs);
        *(u32x4*)(d + q * 8) = pk; }
}

struct S5G { bf16x4 bbf[8]; bf16x8 cmf[4]; bf16x4 uf[2]; bf16x4 df; float lbr, lbi, xr, xi; };
template <bool FINAL>
__device__ __forceinline__ void s5_load(S5G& G, const Params& P, int l, int g, int row0, bool samp, int sb, int tile, int lane) {
    unsigned char* ws = P.ws; const int fr = lane & 15, fq = lane >> 4, p = lane;
    const float* lb = (const float*)(ws + OFF_LB) + (size_t)l * 4 * 2048;
    G.lbr = lb[g * 64 + p]; G.lbi = lb[2048 + g * 64 + p]; G.xr = 0.f; G.xi = 0.f; G.df = (bf16x4){0, 0, 0, 0};
    if (FINAL) { if (samp) { G.xr = P.in[4][((size_t)(l * 8 + sb) * 32 + g) * 64 + p]; G.xi = P.in[5][((size_t)(l * 8 + sb) * 32 + g) * 64 + p]; }
                 else { const float* cc = (const float*)(ws + OFF_S5C) + (size_t)tile * 4096; G.xr = cc[g * 64 + p]; G.xi = cc[2048 + g * 64 + p]; } }
    const bf16_t* bb = (const bf16_t*)(ws + OFF_BB) + ((size_t)(l * 32 + g) * 128) * 16;
#pragma unroll
    for (int nt = 0; nt < 8; ++nt) G.bbf[nt] = *(const bf16x4*)(bb + (size_t)(nt * 16 + fr) * 16 + fq * 4);
    const bf16_t* Z = (const bf16_t*)(ws + OFF_Z);
    if (FINAL) { const bf16_t* cm = (const bf16_t*)(ws + OFF_CM) + ((size_t)(l * 32 + g) * 16 + fr) * 128;
#pragma unroll
        for (int kk = 0; kk < 4; ++kk) G.cmf[kk] = *(const bf16x8*)(cm + kk * 32 + fq * 8);
        { const short dv = (short)f2bf(P.in[21][l * 512 + g * 16 + fr]); G.df[0] = (fq * 4 + 0 == fr) ? dv : (short)0; G.df[1] = (fq * 4 + 1 == fr) ? dv : (short)0; G.df[2] = (fq * 4 + 2 == fr) ? dv : (short)0; G.df[3] = (fq * 4 + 3 == fr) ? dv : (short)0; } }
#pragma unroll
    for (int sub = 0; sub < 2; ++sub) { const bf16_t* zu = Z + (size_t)(row0 + sub * 16) * INW + 1024 + g * 16;
        G.uf[sub] = *(const bf16x4*)(zu + (size_t)fr * INW + fq * 4);
    }
}

__device__ __forceinline__ void lru_final_fast(const Params& P, int l, int tile, int tid) {
    unsigned char* ws = P.ws; const int tok = tid >> 4, part = tid & 15, row = tile * 32 + tok;
    const unsigned* hl = (const unsigned*)(ws + OFF_HL) + (size_t)(row >> 1) * 512 + part * 32; const unsigned* pl = (const unsigned*)(ws + OFF_PL) + (size_t)(row >> 1) * 512 + part * 32;
    const bf16_t* gz = (const bf16_t*)(ws + OFF_Z) + (size_t)row * INW + 512 + part * 32; const float* cc = (const float*)(ws + OFF_LRUC) + (size_t)tile * 512 + part * 32;
    u32x4 hv[8], pv[8], gv[4]; f32x4 cv[8];
#pragma unroll
    for (int q = 0; q < 8; ++q) { hv[q] = *(const u32x4*)(hl + q * 4); pv[q] = *(const u32x4*)(pl + q * 4); cv[q] = *(const f32x4*)(cc + q * 4); }
#pragma unroll
    for (int q = 0; q < 4; ++q) gv[q] = *(const u32x4*)(gz + q * 8);
    const bool odd = row & 1;
    float v[32]; float sq = 0.f;
#pragma unroll
    for (int ci = 0; ci < 32; ++ci) {
        const unsigned hw = hv[ci >> 2][ci & 3], pw = pv[ci >> 2][ci & 3], gw = gv[ci >> 3][(ci >> 1) & 3];
        const float h0 = odd ? __uint_as_float(hw & 0xFFFF0000u) : __uint_as_float(hw << 16), p0 = odd ? __uint_as_float(pw & 0xFFFF0000u) : __uint_as_float(pw << 16),
                    g0 = (ci & 1) ? __uint_as_float(gw & 0xFFFF0000u) : __uint_as_float(gw << 16);
        const float y = (h0 + p0 * cv[ci >> 2][ci & 3]) * gelu_t(g0); v[ci] = y; sq += y * y; }
    sq += __shfl_xor(sq, 1); sq += __shfl_xor(sq, 2); sq += __shfl_xor(sq, 4); sq += __shfl_xor(sq, 8);
    const float rs = rsqrtf(sq * (1.f / 512.f) + EPS);
    bf16_t* d = (bf16_t*)(ws + OFF_MIX) + (size_t)row * 1024 + part * 32;
#pragma unroll
    for (int q = 0; q < 4; ++q) { u32x4 pk;
#pragma unroll
        for (int e = 0; e < 4; ++e) pk[e] = pk_bf16(v[q * 8 + e * 2] * rs, v[q * 8 + e * 2 + 1] * rs);
        *(u32x4*)(d + q * 8) = pk; }
    if (tile == NPT - 1) {
        const int c = tid; const bf16_t* zp = (const bf16_t*)(ws + OFF_Z) + (size_t)(TP - 3) * INW + c; float* oc = P.out + O_CONV_P + (size_t)l * 3 * 512;
        oc[c] = bf2f(zp[0]); oc[512 + c] = bf2f(zp[INW]); oc[1024 + c] = bf2f(zp[2 * INW]);
        P.out[O_LRU_P + (size_t)l * 512 + c] = ((const float*)(ws + OFF_LRUB))[(size_t)tile * 512 + c] + ((const float*)(ws + OFF_LRUA))[(size_t)tile * 512 + c] * ((const float*)(ws + OFF_LRUC))[(size_t)tile * 512 + c];
    }
}

template <bool FINAL, bool FAST = false>
__device__ __forceinline__ void mixer_tile(const Params& P, int l, int tile, unsigned char* lds, const int flags = 3) {
    const int tid = opaque_tid(), wid = tid >> 6, lane = tid & 63, fr = lane & 15, fq = lane >> 4;
    unsigned char* ws = P.ws;
    const bool samp = tile >= NPT; const int sb = tile - NPT;
    const int row0 = samp ? TP + sb * 32 : tile * 32;
    const bool seq_start = samp || tile == 0, seq_end = samp || tile == NPT - 1;
    bf16_t* gtile = (bf16_t*)lds;
    unsigned char* wsc = lds + LDS_GT + wid * LDS_WSC;
    float* regA = (float*)wsc; bf16_t* regB = (bf16_t*)(wsc + LDS_RA);
    const bf16_t* Z = (const bf16_t*)(ws + OFF_Z);
    bf16_t* MIX = (bf16_t*)(ws + OFF_MIX);
    __syncthreads();
    S5G cur;
    if (FAST) { lru_final_fast(P, l, tile, tid); s5_load<FINAL>(cur, P, l, wid * 4, row0, samp, sb, tile, lane); }
    else if (flags & 1) {
        const int c = wid * 64 + lane;
        const bf16_t* zc = Z + (size_t)row0 * INW + c;
        unsigned xraw[16];
#pragma unroll
        for (int t = 0; t < 16; ++t) xraw[t] = (unsigned)zc[(size_t)(2 * t) * INW] | ((unsigned)zc[(size_t)(2 * t + 1) * INW] << 16);
        float x3, x2, x1;
        if (seq_start) { if (samp) { const float* sc = P.in[2] + ((size_t)(l * 8 + sb) * 3) * 512; x3 = sc[c]; x2 = sc[512 + c]; x1 = sc[1024 + c]; } else { x3 = 0.f; x2 = 0.f; x1 = 0.f; } }
        else { const bf16_t* zp = Z + (size_t)(row0 - 3) * INW + c; x3 = bf2f(zp[0]); x2 = bf2f(zp[INW]); x1 = bf2f(zp[2 * INW]); }
        if (FINAL) {
#pragma unroll
            for (int t = 0; t < 32; ++t) gtile[t * 520 + c] = zc[(size_t)t * INW + 512];
        }
        const float* cw = P.in[8] + (size_t)l * 4 * 512; const float cw0 = cw[c], cw1 = cw[512 + c], cw2 = cw[1024 + c], cw3 = cw[1536 + c];
        const float cb = P.in[9][l * 512 + c], ba = P.in[11][l * 512 + c], bx = P.in[13][l * 512 + c];
        const float sp8 = -8.f * log1pf(__expf(-P.in[14][l * 512 + c]));
        float h = 0.f, Pa = 1.f;
        if (FINAL) h = samp ? P.in[3][(size_t)(l * 8 + sb) * 512 + c] : ((const float*)(ws + OFF_LRUC))[(size_t)tile * 512 + c];
        const bf16_t* wa = (const bf16_t*)(ws + OFF_WAX) + ((size_t)(l * 2 + 0) * 8 + wid) * 4096;
        const bf16_t* wx = (const bf16_t*)(ws + OFF_WAX) + ((size_t)(l * 2 + 1) * 8 + wid) * 4096;
        bf16x8 waf[4][2], wxf[4][2];
#pragma unroll
        for (int jt = 0; jt < 4; ++jt)
#pragma unroll
            for (int kk = 0; kk < 2; ++kk) { waf[jt][kk] = *(const bf16x8*)(wa + (jt * 16 + fr) * 64 + kk * 32 + fq * 8); wxf[jt][kk] = *(const bf16x8*)(wx + (jt * 16 + fr) * 64 + kk * 32 + fq * 8); }
        s5_load<FINAL>(cur, P, l, wid * 4, row0, samp, sb, tile, lane);
        bf16_t* xcs = regB; float* pre = regA;
#pragma unroll
        for (int sub = 0; sub < 2; ++sub) {
#pragma unroll
            for (int tt = 0; tt < 16; ++tt) { const float x0 = (tt & 1) ? __uint_as_float(xraw[sub * 8 + (tt >> 1)] & 0xFFFF0000u) : __uint_as_float(xraw[sub * 8 + (tt >> 1)] << 16); const float xc = cb + cw0 * x3 + cw1 * x2 + cw2 * x1 + cw3 * x0; x3 = x2; x2 = x1; x1 = x0; xcs[tt * 72 + lane] = f2bf(xc); }
            WAVE_SYNC();
            f32x4 aa[4], ax[4];
#pragma unroll
            for (int jt = 0; jt < 4; ++jt) { aa[jt] = (f32x4){0.f, 0.f, 0.f, 0.f}; ax[jt] = (f32x4){0.f, 0.f, 0.f, 0.f}; }
#pragma unroll
            for (int kk = 0; kk < 2; ++kk) { const bf16x8 bfv = *(const bf16x8*)(xcs + fr * 72 + kk * 32 + fq * 8);
#pragma unroll
                for (int jt = 0; jt < 4; ++jt) { aa[jt] = __builtin_amdgcn_mfma_f32_16x16x32_bf16(bfv, waf[jt][kk], aa[jt], 0, 0, 0); ax[jt] = __builtin_amdgcn_mfma_f32_16x16x32_bf16(bfv, wxf[jt][kk], ax[jt], 0, 0, 0); } }
#pragma unroll
            for (int jt = 0; jt < 4; ++jt) { *(f32x4*)(pre + (jt * 16 + fr) * 20 + fq * 4) = aa[jt]; *(f32x4*)(pre + 1280 + (jt * 16 + fr) * 20 + fq * 4) = ax[jt]; }
            WAVE_SYNC();
#pragma unroll 2
            for (int q = 0; q < 4; ++q) {
                typedef float f32x2 __attribute__((ext_vector_type(2)));
                const f32x4 pa4 = *(const f32x4*)(pre + lane * 20 + q * 4), px4 = *(const f32x4*)(pre + 1280 + lane * 20 + q * 4);
                const float NL2E = -1.4426950408889634f, sp8l = sp8 * 1.4426950408889634f;
#pragma unroll
                for (int ep = 0; ep < 2; ++ep) { const int tt = q * 4 + 2 * ep;
                    const f32x2 ua = ((f32x2){pa4[2 * ep], pa4[2 * ep + 1]} + (f32x2){ba, ba}) * NL2E, ux = ((f32x2){px4[2 * ep], px4[2 * ep + 1]} + (f32x2){bx, bx}) * NL2E;
                    const f32x2 da = (f32x2){__builtin_amdgcn_exp2f(ua[0]), __builtin_amdgcn_exp2f(ua[1])} + 1.f, dx = (f32x2){__builtin_amdgcn_exp2f(ux[0]), __builtin_amdgcn_exp2f(ux[1])} + 1.f;
                    const f32x2 rg = (f32x2){__builtin_amdgcn_rcpf(da[0]), __builtin_amdgcn_rcpf(da[1])}, ig = (f32x2){__builtin_amdgcn_rcpf(dx[0]), __builtin_amdgcn_rcpf(dx[1])};
                    const f32x2 la = rg * sp8l, av = (f32x2){__builtin_amdgcn_exp2f(la[0]), __builtin_amdgcn_exp2f(la[1])};
                    const f32x2 om = 1.f - av * av;
                    const f32x2 xc = (f32x2){bf2f(xcs[tt * 72 + lane]), bf2f(xcs[(tt + 1) * 72 + lane])};
                    const f32x2 bv = (f32x2){__builtin_amdgcn_sqrtf(fmaxf(om[0], 0.f)), __builtin_amdgcn_sqrtf(fmaxf(om[1], 0.f))} * (ig * xc);
                    const float h0 = av[0] * h + bv[0], p0 = Pa * av[0]; h = av[1] * h0 + bv[1]; Pa = p0 * av[1];
                    if (!FINAL) { ((unsigned*)(ws + OFF_HL))[(size_t)((row0 + sub * 16 + tt) >> 1) * 512 + c] = pk_bf16(h0, h); ((unsigned*)(ws + OFF_PL))[(size_t)((row0 + sub * 16 + tt) >> 1) * 512 + c] = pk_bf16(p0, Pa); }
                    if (FINAL) { bf16_t* gp = gtile + (sub * 16 + tt) * 520 + c; const float gl0 = bf2f(gp[0]), gl1 = bf2f(gp[520]); gp[0] = f2bf(h0 * gelu_t(gl0)); gp[520] = f2bf(h * gelu_t(gl1)); } }
            }
            WAVE_SYNC();
        }
        if (!FINAL) { ((float*)(ws + OFF_LRUA))[(size_t)tile * 512 + c] = Pa; ((float*)(ws + OFF_LRUB))[(size_t)tile * 512 + c] = h; }
        else if (seq_end) {
            float* oc = P.out + (samp ? O_CONV_S + ((size_t)(l * 8 + sb) * 3) * 512 : O_CONV_P + (size_t)l * 3 * 512);
            oc[c] = x3; oc[512 + c] = x2; oc[1024 + c] = x1;
            P.out[(samp ? O_LRU_S + (size_t)(l * 8 + sb) * 512 : O_LRU_P + (size_t)l * 512) + c] = h;
        }
    if (FINAL) { __syncthreads(); norm_store(gtile, MIX + (size_t)row0 * 1024); __syncthreads(); }
    }
    else s5_load<FINAL>(cur, P, l, wid * 4, row0, samp, sb, tile, lane);
    if (flags & 2) {
#pragma unroll
    for (int gi = 0; gi < 4; ++gi) {
        const int g = wid * 4 + gi, p = lane;
        S5G nxt;
        if (gi < 3) s5_load<FINAL>(nxt, P, l, g + 1, row0, samp, sb, tile, lane);
        float xr = cur.xr, xi = cur.xi; const float lbr = cur.lbr, lbi = cur.lbi;
        float* Bu = regA; bf16_t* xs = regB;
#pragma unroll
        for (int sub = 0; sub < 2; ++sub) {
#pragma unroll
            for (int ntp = 0; ntp < 4; ++ntp) {
                const f32x4 dr = __builtin_amdgcn_mfma_f32_16x16x16bf16_1k(cur.uf[sub], cur.bbf[ntp], (f32x4){0.f, 0.f, 0.f, 0.f}, 0, 0, 0);
                const f32x4 di = __builtin_amdgcn_mfma_f32_16x16x16bf16_1k(cur.uf[sub], cur.bbf[ntp + 4], (f32x4){0.f, 0.f, 0.f, 0.f}, 0, 0, 0);
                float* bp = Bu + (ntp * 16 + fr) * 36 + fq * 8;
                *(f32x4*)bp = (f32x4){dr[0], di[0], dr[1], di[1]}; *(f32x4*)(bp + 4) = (f32x4){dr[2], di[2], dr[3], di[3]}; }
            WAVE_SYNC();
            {
                typedef float f32x2 __attribute__((ext_vector_type(2)));
                f32x2 X = (f32x2){xr, xi}; const f32x2 LA = (f32x2){lbr, lbr}, LB = (f32x2){-lbi, lbi};
#pragma unroll
                for (int q = 0; q < 8; ++q) { const f32x4 b4 = *(const f32x4*)(Bu + p * 36 + q * 4);
#pragma unroll
                    for (int e = 0; e < 2; ++e) { const f32x2 bin = (f32x2){b4[2 * e], b4[2 * e + 1]};
                        X = LA * X + (LB * __builtin_shufflevector(X, X, 1, 0) + bin);
                        if (FINAL) ((unsigned*)xs)[(q * 2 + e) * 68 + p] = pk_bf16(X[0], X[1]); } }
                xr = X[0]; xi = X[1];
            }
            if (FINAL) {
                WAVE_SYNC();
                const f32x4 yd = __builtin_amdgcn_mfma_f32_16x16x16bf16_1k(cur.uf[sub], cur.df, (f32x4){0.f, 0.f, 0.f, 0.f}, 0, 0, 0);
                f32x4 y = (f32x4){0.f, 0.f, 0.f, 0.f};
#pragma unroll
                for (int kk = 0; kk < 4; ++kk) { const bf16x8 af = *(const bf16x8*)(xs + fr * 136 + kk * 32 + fq * 8); y = __builtin_amdgcn_mfma_f32_16x16x32_bf16(af, cur.cmf[kk], y, 0, 0, 0); }
#pragma unroll
                for (int r = 0; r < 4; ++r) { const int tok = fq * 4 + r; gtile[(sub * 16 + tok) * 520 + g * 16 + fr] = f2bf(gelu_t(y[r] + yd[r])); }
            }
            WAVE_SYNC();
        }
        if (!FINAL) { float* e = (float*)(ws + OFF_S5E) + (size_t)tile * 4096; e[g * 64 + p] = xr; e[2048 + g * 64 + p] = xi; }
        else if (seq_end) { const size_t o = samp ? ((size_t)(l * 8 + sb) * 32 + g) * 64 + p : ((size_t)l * 32 + g) * 64 + p;
            P.out[(samp ? O_RE_S : O_RE_P) + o] = xr; P.out[(samp ? O_IM_S : O_IM_P) + o] = xi; }
        if (gi < 3) cur = nxt;
    }
    if (FINAL) {
        const bf16_t* wg = (const bf16_t*)(ws + OFF_WGLU + l * SZ_WGLU) + (size_t)(wid * 64 + fr) * 512 + fq * 8;
        bf16x8 bq[2][4][4];
#pragma unroll
        for (int cb = 0; cb < 2; ++cb)
#pragma unroll
            for (int k4 = 0; k4 < 4; ++k4)
#pragma unroll
                for (int nt = 0; nt < 4; ++nt) bq[cb][k4][nt] = *(const bf16x8*)(wg + (size_t)nt * 16 * 512 + (cb * 4 + k4) * 32);
        float bg[4];
#pragma unroll
        for (int nt = 0; nt < 4; ++nt) bg[nt] = P.in[24][l * 512 + wid * 64 + nt * 16 + fr];
        __syncthreads();
        f32x4 acc[2][4];
#pragma unroll
        for (int mt = 0; mt < 2; ++mt)
#pragma unroll
            for (int nt = 0; nt < 4; ++nt) acc[mt][nt] = (f32x4){0.f, 0.f, 0.f, 0.f};
#pragma unroll
        for (int ch = 0; ch < 4; ++ch) {
#pragma unroll
            for (int k4 = 0; k4 < 4; ++k4) { const int kk = ch * 4 + k4;
                bf16x8 af[2];
#pragma unroll
                for (int mt = 0; mt < 2; ++mt) af[mt] = *(const bf16x8*)(gtile + (mt * 16 + fr) * 520 + kk * 32 + fq * 8);
#pragma unroll
                for (int mt = 0; mt < 2; ++mt)
#pragma unroll
                    for (int nt = 0; nt < 4; ++nt) acc[mt][nt] = __builtin_amdgcn_mfma_f32_16x16x32_bf16(af[mt], bq[ch & 1][k4][nt], acc[mt][nt], 0, 0, 0); }
            if (ch < 2) {
#pragma unroll
                for (int k4 = 0; k4 < 4; ++k4)
#pragma unroll
                    for (int nt = 0; nt < 4; ++nt) bq[ch & 1][k4][nt] = *(const bf16x8*)(wg + (size_t)nt * 16 * 512 + ((ch + 2) * 4 + k4) * 32); }
        }
        float o[2][4][4];
#pragma unroll
        for (int mt = 0; mt < 2; ++mt)
#pragma unroll
            for (int nt = 0; nt < 4; ++nt) { const int n = wid * 64 + nt * 16 + fr;
#pragma unroll
                for (int r = 0; r < 4; ++r) o[mt][nt][r] = bf2f(gtile[(mt * 16 + fq * 4 + r) * 520 + n]) * sigm(acc[mt][nt][r] + bg[nt]); }
        __syncthreads();
#pragma unroll
        for (int mt = 0; mt < 2; ++mt)
#pragma unroll
            for (int nt = 0; nt < 4; ++nt)
#pragma unroll
                for (int r = 0; r < 4; ++r) gtile[(mt * 16 + fq * 4 + r) * 520 + wid * 64 + nt * 16 + fr] = f2bf(o[mt][nt][r]);
        __syncthreads();
        norm_store(gtile, MIX + (size_t)row0 * 1024 + 512);
    }
    }
}

__device__ __forceinline__ void carry_phase(const Params& P, int l, unsigned char* lds, const int nitems) {
    unsigned char* ws = P.ws; const int tid = opaque_tid(); const int seg = tid >> 4, ch = tid & 15;
    float* sl = (float*)lds;
    for (int it = blockIdx.x; it < nitems; it += gridDim.x) {
        if (it < 32) {
            const int c = it * 16 + ch; const float* A = (const float*)(ws + OFF_LRUA) + (size_t)(seg * 16) * 512 + c; const float* B = (const float*)(ws + OFF_LRUB) + (size_t)(seg * 16) * 512 + c;
            float a[16], b[16];
#pragma unroll
            for (int k = 0; k < 16; ++k) { a[k] = A[(size_t)k * 512]; b[k] = B[(size_t)k * 512]; }
            float pa = 1.f, pb = 0.f;
#pragma unroll
            for (int k = 0; k < 16; ++k) { pb = a[k] * pb + b[k]; pa *= a[k]; }
            __syncthreads();
            sl[seg * 16 + ch] = pa; sl[512 + seg * 16 + ch] = pb;
            __syncthreads();
            float cs = 0.f;
            for (int s2 = 0; s2 < seg; ++s2) cs = sl[s2 * 16 + ch] * cs + sl[512 + s2 * 16 + ch];
            float* C = (float*)(ws + OFF_LRUC) + (size_t)(seg * 16) * 512 + c;
#pragma unroll
            for (int k = 0; k < 16; ++k) { C[(size_t)k * 512] = cs; cs = a[k] * cs + b[k]; }
        } else if (it < 160) {
            const int idx = (it - 32) * 16 + ch; const float* lb = (const float*)(ws + OFF_LB) + (size_t)l * 4 * 2048; const float qr = lb[4096 + idx], qi = lb[6144 + idx];
            const float* E = (const float*)(ws + OFF_S5E) + (size_t)(seg * 16) * 4096 + idx;
            float er[16], ei[16];
#pragma unroll
            for (int k = 0; k < 16; ++k) { er[k] = E[(size_t)k * 4096]; ei[k] = E[(size_t)k * 4096 + 2048]; }
            float xr = 0.f, xi = 0.f;
#pragma unroll
            for (int k = 0; k < 16; ++k) { const float nr = qr * xr - qi * xi + er[k], ni = qr * xi + qi * xr + ei[k]; xr = nr; xi = ni; }
            float q16r = qr, q16i = qi;
#pragma unroll
            for (int s2 = 0; s2 < 4; ++s2) { const float t = q16r * q16r - q16i * q16i; q16i = 2.f * q16r * q16i; q16r = t; }
            __syncthreads();
            sl[seg * 16 + ch] = xr; sl[512 + seg * 16 + ch] = xi;
            __syncthreads();
            float cr = 0.f, ci = 0.f;
            for (int s2 = 0; s2 < seg; ++s2) { const float nr = q16r * cr - q16i * ci + sl[s2 * 16 + ch], ni = q16r * ci + q16i * cr + sl[512 + s2 * 16 + ch]; cr = nr; ci = ni; }
            float* C = (float*)(ws + OFF_S5C) + (size_t)(seg * 16) * 4096 + idx;
#pragma unroll
            for (int k = 0; k < 16; ++k) { C[(size_t)k * 4096] = cr; C[(size_t)k * 4096 + 2048] = ci; const float nr = qr * cr - qi * ci + er[k], ni = qr * ci + qi * cr + ei[k]; cr = nr; ci = ni; }
        } else mixer_tile<true>(P, l, NPT + ((it - 160) & 7), lds, it < 168 ? 1 : 2);
    }
}

__device__ __forceinline__ void final_norm(const Params& P) {
    const float* ss = (const float*)(P.ws + OFF_SS) + 4 * TT; const int tid = opaque_tid(); const bf16_t* XB = (const bf16_t*)(P.ws + OFF_XB);
    const int cg = (tid & 127) * 8;
    const float4 g0 = *(const float4*)(P.in[32] + cg), g1 = *(const float4*)(P.in[32] + cg + 4);
    for (int r0 = blockIdx.x * 4 + (tid >> 7); r0 < TP; r0 += gridDim.x * 4 * 4) {
        u32x4 w[4]; float rs[4];
#pragma unroll
        for (int j = 0; j < 4; ++j) { const int row = r0 + j * gridDim.x * 4; if (row < TP) { w[j] = *(const u32x4*)(XB + (size_t)row * 1024 + cg); rs[j] = ss[row]; } }
#pragma unroll
        for (int j = 0; j < 4; ++j) { const int row = r0 + j * gridDim.x * 4; if (row < TP) { const float q = rsqrtf(rs[j] * (1.f / 1024.f) + EPS); float4 a, b;
            a.x = __uint_as_float(w[j][0] << 16) * q * g0.x; a.y = __uint_as_float(w[j][0] & 0xFFFF0000u) * q * g0.y; a.z = __uint_as_float(w[j][1] << 16) * q * g0.z; a.w = __uint_as_float(w[j][1] & 0xFFFF0000u) * q * g0.w;
            b.x = __uint_as_float(w[j][2] << 16) * q * g1.x; b.y = __uint_as_float(w[j][2] & 0xFFFF0000u) * q * g1.y; b.z = __uint_as_float(w[j][3] << 16) * q * g1.z; b.w = __uint_as_float(w[j][3] & 0xFFFF0000u) * q * g1.w;
            *(float4*)(P.out + (size_t)row * 1024 + cg) = a; *(float4*)(P.out + (size_t)row * 1024 + cg + 4) = b; } }
    }
    const int wid = tid >> 6, lane = tid & 63;
    for (int r = blockIdx.x + wid * gridDim.x; r < 256; r += gridDim.x * 8) { const bf16_t* xb = XB + (size_t)(TP + r) * 1024; float* xr = P.out + (size_t)(TP + r) * 1024; float4 v[4]; float sq = 0.f;
#pragma unroll
        for (int j = 0; j < 4; ++j) { const u32x2 w = *(const u32x2*)(xb + j * 256 + lane * 4); v[j].x = __uint_as_float(w[0] << 16); v[j].y = __uint_as_float(w[0] & 0xFFFF0000u); v[j].z = __uint_as_float(w[1] << 16); v[j].w = __uint_as_float(w[1] & 0xFFFF0000u); }
        for (int s0 = 0; s0 < 11; s0 += 4) {
            float4 w[4][4];
#pragma unroll
            for (int b = 0; b < 4; ++b) if (s0 + b < 11) { const float* pr = (const float*)(P.ws + OFF_PART) + ((size_t)(s0 + b) * 256 + r) * 1024;
#pragma unroll
                for (int j = 0; j < 4; ++j) w[b][j] = *(const float4*)(pr + j * 256 + lane * 4); }
#pragma unroll
            for (int b = 0; b < 4; ++b) if (s0 + b < 11) {
#pragma unroll
                for (int j = 0; j < 4; ++j) { v[j].x += w[b][j].x; v[j].y += w[b][j].y; v[j].z += w[b][j].z; v[j].w += w[b][j].w; } } }
#pragma unroll
        for (int j = 0; j < 4; ++j) sq += v[j].x * v[j].x + v[j].y * v[j].y + v[j].z * v[j].z + v[j].w * v[j].w;
#pragma unroll
        for (int o = 1; o < 64; o <<= 1) sq += __shfl_xor(sq, o);
        const float rs = rsqrtf(sq * (1.f / 1024.f) + EPS);
#pragma unroll
        for (int j = 0; j < 4; ++j) { const float4 g = *(const float4*)(P.in[32] + j * 256 + lane * 4); v[j].x *= rs * g.x; v[j].y *= rs * g.y; v[j].z *= rs * g.z; v[j].w *= rs * g.w; *(float4*)(xr + j * 256 + lane * 4) = v[j]; } }
}

#define GSYNC() do { XcdBarrier xb_; xb_.bar = (unsigned*)(P.ws + OFF_BAR); xb_.x = (unsigned)__builtin_amdgcn_readfirstlane((int)xb_xcc_id()); xb_.st = (volatile LAS unsigned*)(shm + LDS_XB); xcd_barrier(xb_); } while (0)
__global__ void __launch_bounds__(512, 2) hymba_fwd(Params P) {
    extern __shared__ __attribute__((aligned(16))) unsigned char shm[];
    cg::grid_group grid = cg::this_grid();
    unsigned char* ws = P.ws;
    float* ss = (float*)(ws + OFF_SS);
    bf16_t* XB = (bf16_t*)(ws + OFF_XB);
    unsigned* ctrs = (unsigned*)(ws + OFF_BAR) + CTR_WORD0;
    if (threadIdx.x < 4) ((volatile unsigned*)(shm + LDS_XB))[threadIdx.x] = 0u;
    __syncthreads();
    if (threadIdx.x == 0) (void)xb_add(&((unsigned*)(ws + OFF_BAR))[XB_XCNT((unsigned)__builtin_amdgcn_readfirstlane((int)xb_xcc_id()))], 1u);
    if (P.out == nullptr) grid.sync();
    prep_phase(P, shm);
    GSYNC();
    for (int l = 0; l < 2; ++l) {
        if (l) sample_fix(P, 11, ss + (size_t)(2 * l) * TT, ctrs + 128, 166);
        const int g1_first = (65 * 6) % (int)gridDim.x, g1_idle = (int)gridDim.x - g1_first; const bool early_sample = (65 * 6 > (int)gridDim.x) && g1_idle >= 32 && (int)gridDim.x >= 176;
        run_gemm_g1(shm, XB, (const bf16_t*)(ws + OFF_WIN + l * SZ_WIN), INW, DM, EpiZ{(bf16_t*)(ws + OFF_Z), ss + (size_t)(2 * l) * TT}, l ? ctrs + 128 : nullptr, early_sample ? ctrs + 192 + 64 * l : nullptr);
        if (early_sample) {
            const int rk = (int)blockIdx.x - g1_first;
            if (rk >= 0 && rk < 16) { wait_counter(ctrs + 192 + 64 * l, 6 * 8); mixer_tile<true>(P, l, NPT + (rk & 7), shm, rk < 8 ? 1 : 2); }
            else if (rk >= 16 && l == 0) convert_range(P, 1664, 384, 1664, 0, rk - 16, g1_idle - 16, shm);
        } else if (l == 0) convert_by_idle(P, 65 * 6, 1664, 384, 1664, 0, shm);
        GSYNC();
        for (int t = blockIdx.x; t < NPT; t += gridDim.x) mixer_tile<false>(P, l, t, shm);
        GSYNC();
        carry_phase(P, l, shm, early_sample ? 160 : 176);
        if (early_sample && (int)blockIdx.x >= 160 && (int)blockIdx.x < 176)
            run_gemm_sample_split(shm, (const bf16_t*)(ws + OFF_MIX), (const bf16_t*)(ws + OFF_WOUT + l * SZ_WOUT), DM, DM, 4, (int)blockIdx.x - 160, EpiRes{XB, ss + (size_t)(2 * l + 1) * TT, (float*)(ws + OFF_PART)});
        if (l == 0) convert_by_idle(P, 176, 704, 2048, 704, 0, shm);
        GSYNC();
        for (int t = blockIdx.x; t < NPT; t += gridDim.x) mixer_tile<true, true>(P, l, t, shm);
        GSYNC();
        if (early_sample) run_gemm(shm, (const bf16_t*)(ws + OFF_MIX), (const bf16_t*)(ws + OFF_WOUT + l * SZ_WOUT), TP, DM, DM, EpiRes{XB, ss + (size_t)(2 * l + 1) * TT, (float*)(ws + OFF_PART)}, nullptr);
        else run_gemm_split(shm, (const bf16_t*)(ws + OFF_MIX), (const bf16_t*)(ws + OFF_WOUT + l * SZ_WOUT), DM, DM, 4,
                 EpiRes{XB, ss + (size_t)(2 * l + 1) * TT, (float*)(ws + OFF_PART)});
        GSYNC();
        sample_fix(P, 4, ss + (size_t)(2 * l + 1) * TT, ctrs + 64 * l, 150);
        run_gemm(shm, XB, (const bf16_t*)(ws + OFF_WGU + l * SZ_WGU), TT, NGU, DM, EpiFF{(bf16_t*)(ws + OFF_FF), ss + (size_t)(2 * l + 1) * TT}, ctrs + 64 * l);
        if (l == 0) convert_by_idle(P, 65 * 22, 2112, 2816, 2048, 704, shm);
        GSYNC();
        run_gemm_split(shm, (const bf16_t*)(ws + OFF_FF), (const bf16_t*)(ws + OFF_WDN + l * SZ_WDN), DM, DFF, 11,
                 EpiRes{XB, ss + (size_t)(2 * l + 2) * TT, (float*)(ws + OFF_PART)});
        if (l == 0) convert_by_idle(P, 256 + 44, 704, 2816 + 2048, 704, 0, shm);
        GSYNC();
    }
    final_norm(P);
}

extern "C" void kernel_launch(void* const* d_in, const int* in_sizes, int n_in, void* d_out, int out_size, void* d_ws, size_t ws_size, hipStream_t stream) {
    static int grid = 0;
    if (grid == 0) {
        if (n_in != 33 || ws_size < WS_END) { fprintf(stderr, "kernel_launch: expected 33 inputs and >= %zu bytes of workspace (got %d, %zu)\n", (size_t)WS_END, n_in, ws_size); grid = -1; return; }
        int dev = 0, cus = 0, per_cu = 0;
        hipGetDevice(&dev); hipDeviceGetAttribute(&cus, hipDeviceAttributeMultiprocessorCount, dev);
        if (hipFuncSetAttribute((const void*)hymba_fwd, hipFuncAttributeMaxDynamicSharedMemorySize, LDS_BYTES) != hipSuccess) { fprintf(stderr, "kernel_launch: hipFuncSetAttribute failed\n"); grid = -1; return; }
        if (hipOccupancyMaxActiveBlocksPerMultiprocessor(&per_cu, (const void*)hymba_fwd, 512, LDS_BYTES) != hipSuccess || per_cu < 1) { fprintf(stderr, "kernel_launch: occupancy query gave %d\n", per_cu); per_cu = 1; }
        (void)hipGetLastError();
        grid = cus * per_cu;
    }
    if (grid < 0) return;
    if (hipMemsetAsync((unsigned char*)d_ws + OFF_BAR, 0, 16384, stream) != hipSuccess) { fprintf(stderr, "kernel_launch: memset of the barrier words failed\n"); return; }
    Params p{};
    for (int i = 0; i < 33; ++i) p.in[i] = (const float*)d_in[i];
    p.out = (float*)d_out; p.ws = (unsigned char*)d_ws;
    void* args[] = {&p};
    hipError_t e = hipLaunchCooperativeKernel((const void*)hymba_fwd, dim3(grid), dim3(512), args, LDS_BYTES, stream);
    if (e != hipSuccess) fprintf(stderr, "cooperative launch failed: %s (grid %d)\n", hipGetErrorString(e), grid);
}
```

```cpp
#include <hip/hip_runtime.h>
#include <hip/hip_cooperative_groups.h>
#include <cstdio>
namespace cg = cooperative_groups;

namespace pg8 {
#define PG8_LAS __attribute__((address_space(3)))
typedef unsigned short bf16_t;
typedef short bf16x8 __attribute__((ext_vector_type(8)));
typedef float f32x4 __attribute__((ext_vector_type(4)));
typedef unsigned u32x4 __attribute__((ext_vector_type(4)));
constexpr int BM = 256, BK = 64, HALF = 128, HTB = HALF * BK * 2  , STAGE_BYTES = 8 * HTB, NXCD = 8, WGM = 8;

__host__ __device__ __forceinline__ int lds_byte(int r, int c) { const int st = (r >> 4) * 2 + (c >> 5), rr = r & 15, cc = c & 31, ob = rr * 64 + cc * 2; return st * 1024 + (ob ^ (((ob >> 9) & 1) << 5)); }
__host__ __device__ __forceinline__ void stage_rc(int b, int& R, int& C) { const int st = b / 1024, sb = b % 1024, swz = sb ^ (((sb >> 9) & 1) << 5); R = (st >> 1) * 16 + swz / 64; C = (st & 1) * 32 + (swz % 64) / 2; }
__host__ __device__ __forceinline__ int perm32(int rho) { const int n = rho >> 4, i = rho & 15; return 8 * (i >> 2) + 4 * n + (i & 3); }

struct Unit { int pm, pn, k0t, nt, part; };
struct Gemm { const bf16_t* A; const bf16_t* Bt; int M, N, K; };

struct StaticOrder {
    int nM, nN, nwg, G, c, ntfull;
    __host__ __device__ void init(int M, int N, int G_, int c_) { nM = M / BM; nN = N / BM; nwg = nM * nN; G = G_; c = c_; ntfull = 0; }
    __host__ __device__ bool next(int i, Unit& u) const {
        const long L = (long)i * G + c; if (L >= nwg) return false;
        int wgid = (int)L; { const int q = nwg / NXCD, r = nwg % NXCD, xcd = wgid % NXCD, off = wgid / NXCD; wgid = (xcd < r ? xcd * (q + 1) : r * (q + 1) + (xcd - r) * q) + off; }
        const int nig = WGM * nN, gid = wgid / nig, fm = gid * WGM, gsz = (nM - fm) < WGM ? (nM - fm) : WGM;
        u.pm = fm + ((wgid % nig) % gsz); u.pn = (wgid % nig) / gsz; u.k0t = 0; u.nt = ntfull; u.part = 0; return true;
    }
    __device__ __forceinline__ void a_ready(const Unit&) const {}
    __device__ __forceinline__ void done(const Unit&) const {}
};
__device__ __forceinline__ unsigned cvt_pk_bf16(float lo, float hi) { unsigned r; asm volatile("v_cvt_pk_bf16_f32 %0, %1, %2" : "=v"(r) : "v"(lo), "v"(hi)); return r; }
template <class Epi, class Sched, bool STAMP = false>
__device__ __forceinline__ void gemm_phase(PG8_LAS unsigned char* lds, const Gemm g, const Sched& S, const Epi& E, unsigned long long* stamps) {
    int tid_ = threadIdx.x; asm volatile("" : "+v"(tid_));
    const int tid = tid_, wid = __builtin_amdgcn_readfirstlane(tid >> 6), lane = tid & 63, wr = wid >> 2, wc = wid & 3, fr = lane & 15, fq = lane >> 4;
    const int K = g.K;
    int ts_lo = 0, ts_hi = 0, nts = 0; const unsigned long long rt_entry = STAMP ? (unsigned long long)wall_clock64() : 0ull;
#define PG8_STAMP() do { if (STAMP && wid == 0 && nts < 64) { const unsigned long long _c = (unsigned long long)clock64(); \
        ts_lo = (lane == nts) ? (int)(unsigned)_c : ts_lo; ts_hi = (lane == nts) ? (int)(unsigned)(_c >> 32) : ts_hi; ++nts; } } while (0)
    PG8_STAMP();
    unsigned voffA[2], voffB[2];
#pragma unroll
    for (int i = 0; i < 2; ++i) { int R, C; stage_rc(tid * 16 + i * 8192, R, C); const int Rb = Epi::PERM ? ((R & ~31) + perm32(R & 31)) : R;
        voffA[i] = (unsigned)(R * K + C) * 2u; voffB[i] = (unsigned)(Rb * K + C) * 2u; }
    const size_t kstep = (size_t)(BK * 2);
    const size_t hstep = (size_t)HALF * K * 2;
    const size_t tstep = 2 * hstep;
    const unsigned ldsw = (unsigned)wid * 1024u;
    const int aoff = lds_byte(wr * 64 + fr, fq * 8), boff = lds_byte(wc * 32 + fr, fq * 8);
#define PG8_SA(b, h) (((b) * 2 + (h)) * HTB)
#define PG8_SB(b, h) ((4 + (b) * 2 + (h)) * HTB)
#define PG8_STAGE(bufoff, gbase, voff) do { _Pragma("unroll") for (int _i = 0; _i < 2; ++_i) \
        __builtin_amdgcn_global_load_lds((const unsigned*)((const char*)(gbase) + (voff)[_i]), (PG8_LAS unsigned*)(lds + (bufoff) + ldsw + _i * 8192), 16, 0, 0); } while (0)
#define PG8_LDA(dst, b, h) do { _Pragma("unroll") for (int m = 0; m < 4; ++m) _Pragma("unroll") for (int k = 0; k < 2; ++k) dst[m][k] = *(const PG8_LAS bf16x8*)(lds + PG8_SA(b, h) + aoff + m * 2048 + k * 1024); } while (0)
#define PG8_LDB(dst, b, h) do { _Pragma("unroll") for (int n = 0; n < 2; ++n) _Pragma("unroll") for (int k = 0; k < 2; ++k) dst[n][k] = *(const PG8_LAS bf16x8*)(lds + PG8_SB(b, h) + boff + n * 2048 + k * 1024); } while (0)
#define PG8_MMA(ai, bj, At, Bt) do { __builtin_amdgcn_s_setprio(1); _Pragma("unroll") for (int m = 0; m < 4; ++m) _Pragma("unroll") for (int n = 0; n < 2; ++n) _Pragma("unroll") for (int k = 0; k < 2; ++k) \
        acc[ai][bj][m][n] = __builtin_amdgcn_mfma_f32_16x16x32_bf16(Bt[n][k], At[m][k], acc[ai][bj][m][n], 0, 0, 0); __builtin_amdgcn_s_setprio(0); } while (0)
#define PG8_WAIT_V(n) asm volatile("s_waitcnt vmcnt(" #n ")" ::: "memory")
#define PG8_WAIT_L(n) asm volatile("s_waitcnt lgkmcnt(" #n ")" ::: "memory")
#define PG8_BAR __builtin_amdgcn_s_barrier()
#define PG8_SCHED __builtin_amdgcn_sched_barrier(0)
    Unit cur, nxt; int ui = 0;
    if (!S.next(0, cur)) return;
    f32x4 acc[2][2][4][2];
#pragma unroll
    for (int a = 0; a < 2; ++a)
#pragma unroll
        for (int b = 0; b < 2; ++b)
#pragma unroll
            for (int m = 0; m < 4; ++m)
#pragma unroll
                for (int n = 0; n < 2; ++n) acc[a][b][m][n] = (f32x4){0.f, 0.f, 0.f, 0.f};
    bf16x8 At[4][2], B0[2][2], B1[2][2];
    const char* cA = (const char*)g.A + (size_t)cur.pm * tstep + (size_t)cur.k0t * kstep; const char* cB = (const char*)g.Bt + (size_t)cur.pn * tstep + (size_t)cur.k0t * kstep;
    S.a_ready(cur);
    PG8_STAGE(PG8_SB(0, 0), cB, voffB); PG8_STAGE(PG8_SA(0, 0), cA, voffA); PG8_STAGE(PG8_SB(0, 1), cB + hstep, voffB); PG8_STAGE(PG8_SA(0, 1), cA + hstep, voffA);
    if (wr == 1) PG8_BAR;
    PG8_WAIT_V(4); PG8_BAR;
    PG8_STAGE(PG8_SB(1, 0), cB + kstep, voffB); PG8_STAGE(PG8_SA(1, 0), cA + kstep, voffA); PG8_STAGE(PG8_SB(1, 1), cB + hstep + kstep, voffB);
    PG8_WAIT_V(6); PG8_BAR;
    PG8_STAMP();
    for (;;) {
        const bool has_next = S.next(ui + 1, nxt);
        const char* nA = has_next ? (const char*)g.A + (size_t)nxt.pm * tstep + (size_t)nxt.k0t * kstep : cA; const char* nB = has_next ? (const char*)g.Bt + (size_t)nxt.pn * tstep + (size_t)nxt.k0t * kstep : cB;
        const int nt = cur.nt;
        for (int t = 0; t < nt; t += 2) {
            const bool last = (t == nt - 2);
            const char* a1 = cA + (size_t)(t + 1) * kstep;
            const char* a2 = last ? nA : cA + (size_t)(t + 2) * kstep; const char* b2 = last ? nB : cB + (size_t)(t + 2) * kstep;
            const char* a3 = a2 + kstep; const char* b3 = b2 + kstep;
            if (last && has_next) S.a_ready(nxt);
            PG8_LDB(B0, 0, 0); PG8_SCHED; PG8_LDA(At, 0, 0); PG8_STAGE(PG8_SA(1, 1), a1 + hstep, voffA);
            PG8_WAIT_L(8); PG8_BAR; PG8_WAIT_L(0); PG8_MMA(0, 0, At, B0); PG8_BAR; PG8_SCHED;
            PG8_LDB(B1, 0, 1); PG8_STAGE(PG8_SB(0, 0), b2, voffB);
            PG8_BAR; PG8_WAIT_L(0); PG8_MMA(0, 1, At, B1); PG8_BAR;
            PG8_LDA(At, 0, 1); PG8_STAGE(PG8_SA(0, 0), a2, voffA);
            PG8_BAR; PG8_WAIT_L(0); PG8_MMA(1, 0, At, B0); PG8_BAR; PG8_SCHED;
            PG8_STAGE(PG8_SB(0, 1), b2 + hstep, voffB);
            PG8_WAIT_V(6); PG8_BAR; PG8_MMA(1, 1, At, B1); PG8_BAR;
            PG8_LDB(B0, 1, 0); PG8_SCHED; PG8_LDA(At, 1, 0); PG8_STAGE(PG8_SA(0, 1), a2 + hstep, voffA);
            PG8_WAIT_L(8); PG8_BAR; PG8_WAIT_L(0); PG8_MMA(0, 0, At, B0); PG8_BAR; PG8_SCHED;
            PG8_LDB(B1, 1, 1); PG8_STAGE(PG8_SB(1, 0), b3, voffB);
            PG8_BAR; PG8_WAIT_L(0); PG8_MMA(0, 1, At, B1); PG8_BAR;
            PG8_LDA(At, 1, 1); PG8_STAGE(PG8_SA(1, 0), a3, voffA);
            PG8_BAR; PG8_WAIT_L(0); PG8_MMA(1, 0, At, B0); PG8_BAR; PG8_SCHED;
            PG8_STAGE(PG8_SB(1, 1), b3 + hstep, voffB);
            PG8_WAIT_V(6); PG8_BAR; PG8_MMA(1, 1, At, B1); PG8_BAR;
        }
        PG8_STAMP();
        if constexpr (!Epi::AFTER_DRAIN) { E(acc, cur, wr, wc, fr, fq); S.done(cur); }
        PG8_STAMP();
        if (!has_next) break;
#pragma unroll
        for (int a = 0; a < 2; ++a)
#pragma unroll
            for (int b = 0; b < 2; ++b)
#pragma unroll
                for (int m = 0; m < 4; ++m)
#pragma unroll
                    for (int n = 0; n < 2; ++n) acc[a][b][m][n] = (f32x4){0.f, 0.f, 0.f, 0.f};
        cur = nxt; cA = nA; cB = nB; ++ui;
    }
    PG8_WAIT_V(0);
    if (wr == 0) PG8_BAR;
    PG8_BAR;
    if constexpr (Epi::AFTER_DRAIN) { E.fused(acc, cur, wr, wc, fr, fq, lds, wid, lane); S.done(cur); }
    PG8_STAMP();
    if (STAMP && wid == 0) { stamps[lane] = lane < nts ? (((unsigned long long)(unsigned)ts_hi << 32) | (unsigned)ts_lo) : 0ull;
        if (lane == 62) stamps[62] = rt_entry; if (lane == 63) stamps[63] = (unsigned long long)wall_clock64(); }
#undef PG8_STAMP
#undef PG8_SA
#undef PG8_SB
#undef PG8_STAGE
#undef PG8_LDA
#undef PG8_LDB
#undef PG8_MMA
#undef PG8_WAIT_V
#undef PG8_WAIT_L
#undef PG8_BAR
#undef PG8_SCHED
}
}
#define XB_TMO      128
#define XB_XCNT(j)  (256  + 64 * (j))
#define XB_XSUB(j)  (1280 + 64 * (j))
#define XB_XGEN(j)  (2304 + 64 * (j))
#define XB_TOP      3328
#define XB_TOPGEN   3392
#define XCD_BAR_WORDS 3456
#define XB_SPIN_CAP (1u << 18)
#define LAS __attribute__((address_space(3)))

__device__ __forceinline__ unsigned xb_ld(unsigned* p)              { return __hip_atomic_load(p, __ATOMIC_RELAXED, __HIP_MEMORY_SCOPE_AGENT); }
__device__ __forceinline__ unsigned xb_add(unsigned* p, unsigned v) { return __hip_atomic_fetch_add(p, v, __ATOMIC_RELAXED, __HIP_MEMORY_SCOPE_AGENT); }
__device__ __forceinline__ unsigned xb_xcc_id() { return (unsigned)__builtin_amdgcn_s_getreg((3 << 11) | 20) & 0xFu; }
#define XB_SPIN(cond, bar) do { unsigned _sp = 0; while (cond) { __builtin_amdgcn_s_sleep(1); \
    if ((++_sp & 255u) == 0u) { if (xb_ld(&(bar)[XB_TMO])) break; if (_sp > XB_SPIN_CAP) { atomicAdd(&(bar)[XB_TMO], 1u); break; } } } } while (0)

struct XcdBarrier {
    unsigned* bar; unsigned x;
    volatile LAS unsigned* st;
};

__device__ __forceinline__ XcdBarrier xcd_barrier_post(unsigned* bar, volatile LAS unsigned* st) {
    XcdBarrier b; b.bar = bar; b.x = xb_xcc_id(); b.st = st;
    if (threadIdx.x == 0) (void)xb_add(&bar[XB_XCNT(b.x)], 1u);
    return b;
}
__device__ __forceinline__ void xcd_barrier_complete(unsigned* bar, unsigned x, unsigned& nloc, unsigned& nx) {
    const unsigned G = gridDim.x * gridDim.y * gridDim.z;
    unsigned sum, cnt, mine, sp = 0u;
    for (;;) {
        sum = 0u; cnt = 0u; mine = 0u;
#pragma unroll
        for (unsigned j = 0; j < 16; ++j) { const unsigned c = xb_ld(&bar[XB_XCNT(j)]); sum += c; cnt += (c > 0u) ? 1u : 0u; mine = (j == x) ? c : mine; }
        if (sum == G) break;
        __builtin_amdgcn_s_sleep(1);
        if ((++sp & 255u) == 0u) { if (xb_ld(&bar[XB_TMO])) break; if (sp > XB_SPIN_CAP) { atomicAdd(&bar[XB_TMO], 1u); break; } }
    }
    nloc = mine > 0u ? mine : 1u; nx = cnt > 0u ? cnt : 1u;
}

__device__ __forceinline__ void xcd_barrier(const XcdBarrier& b) {
    asm volatile("s_waitcnt vmcnt(0)" ::: "memory");
    __syncthreads();
    if (threadIdx.x == 0) {
        unsigned* bar = b.bar;
        __builtin_amdgcn_s_waitcnt(0);
        unsigned nloc = b.st[0], nx = b.st[1];
        if (nloc == 0u) { xcd_barrier_complete(bar, b.x, nloc, nx); b.st[0] = nloc; b.st[1] = nx; }
        const unsigned old = xb_add(&bar[XB_XSUB(b.x)], 1u);
        const unsigned gen = old / nloc;
        if (old + 1u == (gen + 1u) * nloc) {
            __builtin_amdgcn_fence(__ATOMIC_RELEASE, "agent");
            asm volatile("s_waitcnt vmcnt(0)" ::: "memory");
            const unsigned og = xb_add(&bar[XB_TOP], 1u);
            const unsigned tg = og / nx;
            if (og + 1u == (tg + 1u) * nx) xb_add(&bar[XB_TOPGEN], 1u);
            else XB_SPIN(xb_ld(&bar[XB_TOPGEN]) == tg, bar);
            __builtin_amdgcn_fence(__ATOMIC_ACQUIRE, "agent");
            xb_add(&bar[XB_XGEN(b.x)], 1u);
            asm volatile("s_waitcnt vmcnt(0)" ::: "memory");
        } else {
            XB_SPIN(xb_ld(&bar[XB_XGEN(b.x)]) == gen, bar);
            __builtin_amdgcn_fence(__ATOMIC_ACQUIRE, "agent");
            asm volatile("s_waitcnt vmcnt(0)" ::: "memory");
        }
    }
    __syncthreads();
}


using pg8::bf16_t; using pg8::bf16x8; using pg8::f32x4; using pg8::Unit;
typedef short bf16x4 __attribute__((ext_vector_type(4)));
typedef unsigned u32x4 __attribute__((ext_vector_type(4)));
typedef unsigned u32x2 __attribute__((ext_vector_type(2)));

constexpr int TP = 16384, TT = 16640, DM = 1024, INW = 1536, DFF = 2816, NGU = 5632;
constexpr int NPT = 512;
constexpr float EPS = 1e-6f;

constexpr size_t SZ_WIN = (size_t)1536 * 1024 * 2, SZ_WOUT = (size_t)1024 * 1024 * 2, SZ_WGU = (size_t)5632 * 1024 * 2, SZ_WDN = (size_t)1024 * 2816 * 2,
                 SZ_WGLU = (size_t)512 * 512 * 2, SZ_WAX = (size_t)2 * 8 * 64 * 64 * 2;
constexpr size_t OFF_WIN = 0;
constexpr size_t OFF_WOUT = OFF_WIN + 2 * SZ_WIN;
constexpr size_t OFF_WGU = OFF_WOUT + 2 * SZ_WOUT;
constexpr size_t OFF_WDN = OFF_WGU + 2 * SZ_WGU;
constexpr size_t OFF_WGLU = OFF_WDN + 2 * SZ_WDN;
constexpr size_t OFF_WAX = OFF_WGLU + 2 * SZ_WGLU;
constexpr size_t OFF_BB = OFF_WAX + 2 * SZ_WAX;
constexpr size_t OFF_CM = OFF_BB + (size_t)2 * 32 * 128 * 16 * 2;
constexpr size_t OFF_LB = OFF_CM + (size_t)2 * 32 * 16 * 128 * 2;
constexpr size_t OFF_SS = OFF_LB + (size_t)2 * 4 * 2048 * 4;
constexpr size_t OFF_LRUA = OFF_SS + (size_t)5 * TT * 4;
constexpr size_t OFF_LRUB = OFF_LRUA + (size_t)NPT * 512 * 4;
constexpr size_t OFF_LRUC = OFF_LRUB + (size_t)NPT * 512 * 4;
constexpr size_t OFF_S5E = OFF_LRUC + (size_t)NPT * 512 * 4;
constexpr size_t OFF_S5C = OFF_S5E + (size_t)NPT * 2 * 2048 * 4;
constexpr size_t OFF_XB = OFF_S5C + (size_t)NPT * 2 * 2048 * 4;
constexpr size_t OFF_R = OFF_XB + (size_t)TT * 1024 * 2;
constexpr size_t OFF_Z = OFF_R, OFF_MIX = OFF_R + (size_t)TT * 1536 * 2, OFF_FF = OFF_R;
constexpr size_t OFF_BAR = OFF_R + (size_t)TT * 2816 * 2;
constexpr size_t OFF_PART = OFF_BAR + 16384;
constexpr size_t OFF_HL = OFF_PART + (size_t)11 * 256 * 1024 * 4;
constexpr size_t OFF_PL = OFF_HL + (size_t)TP * 512 * 2;
constexpr size_t WS_END = OFF_PL + (size_t)TP * 512 * 2;

constexpr size_t O_Y = 0, O_CONV_P = (size_t)TT * 1024, O_LRU_P = O_CONV_P + 3072, O_RE_P = O_LRU_P + 1024, O_IM_P = O_RE_P + 4096,
                 O_CONV_S = O_IM_P + 4096, O_LRU_S = O_CONV_S + 24576, O_RE_S = O_LRU_S + 8192, O_IM_S = O_RE_S + 32768;

constexpr int LDS_GT = 32 * 520 * 2;
constexpr int LDS_RA = 10240;
constexpr int LDS_WSC = LDS_RA + 4352;
constexpr int LDS_BYTES = 150528;
constexpr int LDS_XB = LDS_BYTES - 16;

struct Params { const float* in[33]; float* out; unsigned char* ws; };

__device__ __forceinline__ unsigned pk_bf16(float lo, float hi) { unsigned r; asm("v_cvt_pk_bf16_f32 %0, %1, %2" : "=v"(r) : "v"(lo), "v"(hi)); return r; }
__device__ __forceinline__ bf16_t f2bf(float f) { return (bf16_t)pk_bf16(f, f); }
__device__ __forceinline__ float bf2f(bf16_t b) { return __uint_as_float(((unsigned)b) << 16); }
__device__ __forceinline__ float sigm(float x) { return __builtin_amdgcn_rcpf(1.f + __expf(-x)); }
__device__ __forceinline__ float gelu_t(float x) { return x * sigm(1.5957691216057308f * (x + 0.044715f * x * x * x)); }
__device__ __forceinline__ int opaque_tid() { int t = threadIdx.x; asm volatile("" : "+v"(t)); return t; }
#define WAVE_SYNC() do { __builtin_amdgcn_fence(__ATOMIC_RELEASE, "wavefront"); __builtin_amdgcn_wave_barrier(); __builtin_amdgcn_fence(__ATOMIC_ACQUIRE, "wavefront"); } while (0)

struct EpiZ {
    static constexpr bool PERM = true, AFTER_DRAIN = false;
    bf16_t* O; const float* ss;
    __device__ __forceinline__ void operator()(const f32x4 (&acc)[2][2][4][2], const Unit& u, int wr, int wc, int fr, int fq) const {
        const int row0 = u.pm * 256 + wr * 64 + fr, col0 = u.pn * 256 + wc * 32 + 8 * fq;
        float rs[2][4];
#pragma unroll
        for (int ai = 0; ai < 2; ++ai)
#pragma unroll
            for (int m = 0; m < 4; ++m) rs[ai][m] = ss[row0 + ai * 128 + m * 16];
#pragma unroll
        for (int ai = 0; ai < 2; ++ai)
#pragma unroll
            for (int m = 0; m < 4; ++m) {
                const int row = row0 + ai * 128 + m * 16; const float r1 = rsqrtf(rs[ai][m] * (1.f / 1024.f) + EPS);
                bf16_t* rp = O + (size_t)row * INW + col0;
#pragma unroll
                for (int bj = 0; bj < 2; ++bj) { const f32x4 v0 = acc[ai][bj][m][0] * r1, v1 = acc[ai][bj][m][1] * r1;
                    u32x4 pk; pk[0] = pk_bf16(v0[0], v0[1]); pk[1] = pk_bf16(v0[2], v0[3]); pk[2] = pk_bf16(v1[0], v1[1]); pk[3] = pk_bf16(v1[2], v1[3]);
                    *(u32x4*)(rp + bj * 128) = pk; }
            }
    }
};
struct EpiFF {
    static constexpr bool PERM = true, AFTER_DRAIN = false;
    bf16_t* O; const float* ss;
    __device__ __forceinline__ void operator()(const f32x4 (&acc)[2][2][4][2], const Unit& u, int wr, int wc, int fr, int fq) const {
        const int row0 = u.pm * 256 + wr * 64 + fr, f0 = u.pn * 128 + wc * 32 + 8 * fq;
        float rs[2][4];
#pragma unroll
        for (int ai = 0; ai < 2; ++ai)
#pragma unroll
            for (int m = 0; m < 4; ++m) rs[ai][m] = ss[row0 + ai * 128 + m * 16];
#pragma unroll
        for (int ai = 0; ai < 2; ++ai)
#pragma unroll
            for (int m = 0; m < 4; ++m) {
                const int row = row0 + ai * 128 + m * 16; const float r1 = rsqrtf(rs[ai][m] * (1.f / 1024.f) + EPS), r2 = r1 * -1.4426950408889634f;
                float o[8];
#pragma unroll
                for (int n = 0; n < 2; ++n)
#pragma unroll
                    for (int i = 0; i < 4; ++i) { const float ag = acc[ai][0][m][n][i];
                        o[n * 4 + i] = (ag * r1) * (acc[ai][1][m][n][i] * r1) * __builtin_amdgcn_rcpf(1.f + __builtin_amdgcn_exp2f(ag * r2)); }
                u32x4 pk; pk[0] = pk_bf16(o[0], o[1]); pk[1] = pk_bf16(o[2], o[3]); pk[2] = pk_bf16(o[4], o[5]); pk[3] = pk_bf16(o[6], o[7]);
                *(u32x4*)(O + (size_t)row * DFF + f0) = pk;
            }
    }
};
struct EpiRes {
    static constexpr bool PERM = true, AFTER_DRAIN = false;
    bf16_t* xb; float* ss; float* part;
    __device__ __forceinline__ void operator()(const f32x4 (&acc)[2][2][4][2], const Unit& u, int wr, int wc, int fr, int fq) const {
        const int row0 = u.pm * 256 + wr * 64 + fr, col0 = u.pn * 256 + wc * 32 + 8 * fq;
        if (u.part) {
            float* pb = part + ((size_t)(u.k0t / u.nt) * 256 + (wr * 64 + fr)) * 1024 + col0;
#pragma unroll
            for (int ai = 0; ai < 2; ++ai)
#pragma unroll
                for (int m = 0; m < 4; ++m) { float* op = pb + (size_t)(ai * 128 + m * 16) * 1024;
#pragma unroll
                    for (int bj = 0; bj < 2; ++bj)
#pragma unroll
                        for (int n = 0; n < 2; ++n) *(f32x4*)(op + bj * 128 + 4 * n) = acc[ai][bj][m][n]; }
            return;
        }
#pragma unroll
        for (int ai = 0; ai < 2; ++ai) {
            u32x4 xv[4][2];
#pragma unroll
            for (int m = 0; m < 4; ++m)
#pragma unroll
                for (int bj = 0; bj < 2; ++bj) xv[m][bj] = *(const u32x4*)(xb + (size_t)(row0 + ai * 128 + m * 16) * 1024 + col0 + bj * 128);
#pragma unroll
            for (int m = 0; m < 4; ++m) {
                const int row = row0 + ai * 128 + m * 16; bf16_t* bp = xb + (size_t)row * 1024 + col0; float sq = 0.f;
#pragma unroll
                for (int bj = 0; bj < 2; ++bj) { const u32x4 w = xv[m][bj]; u32x4 pk;
#pragma unroll
                    for (int n = 0; n < 2; ++n) { const f32x4 a = acc[ai][bj][m][n];
                        const float v0 = __uint_as_float(w[2 * n] << 16) + a[0], v1 = __uint_as_float(w[2 * n] & 0xFFFF0000u) + a[1], v2 = __uint_as_float(w[2 * n + 1] << 16) + a[2], v3 = __uint_as_float(w[2 * n + 1] & 0xFFFF0000u) + a[3];
                        pk[2 * n] = pk_bf16(v0, v1); pk[2 * n + 1] = pk_bf16(v2, v3); sq += v0 * v0 + v1 * v1 + v2 * v2 + v3 * v3; }
                    *(u32x4*)(bp + bj * 128) = pk; }
                sq += __shfl_xor(sq, 16); sq += __shfl_xor(sq, 32);
                if (fq == 0) atomicAdd(ss + row, sq);
            }
        }
    }
};
struct SplitOrder : pg8::StaticOrder {
    int nwgP, nsplit, ntS, nNs;
    __device__ __forceinline__ void init2(int N, int K, int G_, int c_, int nsplit_) { init(TP, N, G_, c_); ntfull = K / 64; nwgP = nwg; nNs = N / 256; nsplit = nsplit_; ntS = ntfull / nsplit_; }
    __device__ __forceinline__ bool next(int i, Unit& u) const {
        const long L = (long)i * G + c;
        if (L < nwgP) return pg8::StaticOrder::next(i, u);
        const int sidx = (int)(L - nwgP); if (sidx >= nNs * nsplit) return false;
        u.pm = 64; u.pn = sidx % nNs; u.k0t = (sidx / nNs) * ntS; u.nt = ntS; u.part = 1; return true;
    }
};
__device__ __forceinline__ void sample_fix(const Params& P, int nsplit, float* ss_out, unsigned* ctr, int first_wg) {
    const int tid = opaque_tid(), wid = tid >> 6, lane = tid & 63; const float* part = (const float*)(P.ws + OFF_PART);
    if ((int)gridDim.x < first_wg + 32) first_wg = 0;
    for (int r = ((int)blockIdx.x - first_wg) * 8 + wid; r >= 0 && r < 256; r += 256) { const int row = TP + r; bf16_t* xb = (bf16_t*)(P.ws + OFF_XB) + (size_t)row * 1024; float sq = 0.f;
        float4 v[4];
#pragma unroll
        for (int j = 0; j < 4; ++j) { const u32x2 w = *(const u32x2*)(xb + j * 256 + lane * 4); v[j].x = __uint_as_float(w[0] << 16); v[j].y = __uint_as_float(w[0] & 0xFFFF0000u); v[j].z = __uint_as_float(w[1] << 16); v[j].w = __uint_as_float(w[1] & 0xFFFF0000u); }
        for (int s0 = 0; s0 < nsplit; s0 += 4) {
            float4 w[4][4];
#pragma unroll
            for (int b = 0; b < 4; ++b) if (s0 + b < nsplit) { const float* pr = part + ((size_t)(s0 + b) * 256 + r) * 1024;
#pragma unroll
                for (int j = 0; j < 4; ++j) w[b][j] = *(const float4*)(pr + j * 256 + lane * 4); }
#pragma unroll
            for (int b = 0; b < 4; ++b) if (s0 + b < nsplit) {
#pragma unroll
                for (int j = 0; j < 4; ++j) { v[j].x += w[b][j].x; v[j].y += w[b][j].y; v[j].z += w[b][j].z; v[j].w += w[b][j].w; } } }
#pragma unroll
        for (int j = 0; j < 4; ++j) { sq += v[j].x * v[j].x + v[j].y * v[j].y + v[j].z * v[j].z + v[j].w * v[j].w;
            u32x2 pk; pk[0] = pk_bf16(v[j].x, v[j].y); pk[1] = pk_bf16(v[j].z, v[j].w); *(u32x2*)(xb + j * 256 + lane * 4) = pk; }
#pragma unroll
        for (int o = 1; o < 64; o <<= 1) sq += __shfl_xor(sq, o);
        if (lane == 0) ss_out[row] = sq;
        __builtin_amdgcn_fence(__ATOMIC_RELEASE, "agent");
        asm volatile("s_waitcnt vmcnt(0)" ::: "memory");
        if (lane == 0) __hip_atomic_fetch_add(ctr, 1u, __ATOMIC_RELAXED, __HIP_MEMORY_SCOPE_AGENT); }
}
constexpr int CTR_WORD0 = 3584;
struct WaitOrder : pg8::StaticOrder {
    const unsigned* ready;
    __device__ __forceinline__ void a_ready(const Unit& u) const {
        if (ready == nullptr || u.pm != 64) return;
        if (threadIdx.x < 64) {
            unsigned polls = 0;
            while ((unsigned)__builtin_amdgcn_readfirstlane((int)__hip_atomic_load(ready, __ATOMIC_RELAXED, __HIP_MEMORY_SCOPE_AGENT)) < 256u) { if (++polls > (1u << 22)) break; __builtin_amdgcn_s_sleep(2); }
            __builtin_amdgcn_fence(__ATOMIC_ACQUIRE, "agent");
            asm volatile("s_waitcnt vmcnt(0)" ::: "memory");
        }
        asm volatile("" ::: "memory"); __builtin_amdgcn_s_barrier(); asm volatile("" ::: "memory");
    }
};
template <class Epi> __device__ __forceinline__ void run_gemm(unsigned char* lds, const bf16_t* A, const bf16_t* Bt, int M, int N, int K, const Epi& E, const unsigned* ready) {
    pg8::Gemm g{A, Bt, M, N, K}; WaitOrder S; S.init(M, N, (int)gridDim.x, (int)blockIdx.x); S.ntfull = K / 64; S.ready = ready;
    pg8::gemm_phase<Epi, WaitOrder, false>((PG8_LAS unsigned char*)lds, g, S, E, nullptr);
}
struct SampleFirstOrder : pg8::StaticOrder {
    const unsigned* ready; unsigned* donectr; int nNs;
    __device__ __forceinline__ void init3(int N, int K, int G_, int c_) { init(TP, N, G_, c_); ntfull = K / 64; nNs = N / 256; }
    __device__ __forceinline__ bool next(int i, Unit& u) const {
        long L = (long)i * G + c; u.k0t = 0; u.nt = ntfull; u.part = 0;
        if (L < nNs) { u.pm = 64; u.pn = (int)L; return true; }
        L -= nNs; if (L >= nwg) return false;
        int wgid = (int)L; { const int q = nwg / pg8::NXCD, r = nwg % pg8::NXCD, xcd = wgid % pg8::NXCD, off = wgid / pg8::NXCD; wgid = (xcd < r ? xcd * (q + 1) : r * (q + 1) + (xcd - r) * q) + off; }
        const int nig = pg8::WGM * nN, gid = wgid / nig, fm = gid * pg8::WGM, gsz = (nM - fm) < pg8::WGM ? (nM - fm) : pg8::WGM;
        u.pm = fm + ((wgid % nig) % gsz); u.pn = (wgid % nig) / gsz; return true;
    }
    __device__ __forceinline__ void a_ready(const Unit& u) const {
        if (ready == nullptr || u.pm != 64) return;
        if (threadIdx.x < 64) {
            unsigned polls = 0;
            while ((unsigned)__builtin_amdgcn_readfirstlane((int)__hip_atomic_load(ready, __ATOMIC_RELAXED, __HIP_MEMORY_SCOPE_AGENT)) < 256u) { if (++polls > (1u << 22)) break; __builtin_amdgcn_s_sleep(2); }
            __builtin_amdgcn_fence(__ATOMIC_ACQUIRE, "agent");
            asm volatile("s_waitcnt vmcnt(0)" ::: "memory");
        }
        asm volatile("" ::: "memory"); __builtin_amdgcn_s_barrier(); asm volatile("" ::: "memory");
    }
    __device__ __forceinline__ void done(const Unit& u) const {
        if (u.pm != 64 || donectr == nullptr) return;
        __builtin_amdgcn_fence(__ATOMIC_RELEASE, "agent"); asm volatile("s_waitcnt vmcnt(0)" ::: "memory");
        if ((threadIdx.x & 63) == 0) __hip_atomic_fetch_add(donectr, 1u, __ATOMIC_RELAXED, __HIP_MEMORY_SCOPE_AGENT);
    }
};
template <class Epi> __device__ __forceinline__ void run_gemm_g1(unsigned char* lds, const bf16_t* A, const bf16_t* Bt, int N, int K, const Epi& E, const unsigned* ready, unsigned* donectr) {
    pg8::Gemm g{A, Bt, TT, N, K}; SampleFirstOrder S; S.init3(N, K, (int)gridDim.x, (int)blockIdx.x); S.ready = ready; S.donectr = donectr;
    pg8::gemm_phase<Epi, SampleFirstOrder, false>((PG8_LAS unsigned char*)lds, g, S, E, nullptr);
}
template <class Epi> __device__ __forceinline__ void run_gemm_sample_split(unsigned char* lds, const bf16_t* A, const bf16_t* Bt, int N, int K, int nsplit, int rank, const Epi& E) {
    pg8::Gemm g{A, Bt, TT, N, K}; SplitOrder S; S.init2(N, K, 1 << 20, rank, nsplit); S.nwgP = 0;
    pg8::gemm_phase<Epi, SplitOrder, false>((PG8_LAS unsigned char*)lds, g, S, E, nullptr);
}
__device__ __forceinline__ void wait_counter(const unsigned* ctr, unsigned need) {
    if (threadIdx.x < 64) {
        unsigned polls = 0;
        while ((unsigned)__builtin_amdgcn_readfirstlane((int)__hip_atomic_load(ctr, __ATOMIC_RELAXED, __HIP_MEMORY_SCOPE_AGENT)) < need) { if (++polls > (1u << 22)) break; __builtin_amdgcn_s_sleep(2); }
        __builtin_amdgcn_fence(__ATOMIC_ACQUIRE, "agent");
        asm volatile("s_waitcnt vmcnt(0)" ::: "memory");
    }
    __syncthreads();
}
template <class Epi> __device__ __forceinline__ void run_gemm_split(unsigned char* lds, const bf16_t* A, const bf16_t* Bt, int N, int K, int nsplit, const Epi& E) {
    pg8::Gemm g{A, Bt, TT, N, K}; SplitOrder S; S.init2(N, K, (int)gridDim.x, (int)blockIdx.x, nsplit);
    pg8::gemm_phase<Epi, SplitOrder, false>((PG8_LAS unsigned char*)lds, g, S, E, nullptr);
}

struct TrTile { const float* src; const float* gain; bf16_t* dst; int N, K, k0, n0, drow; };
__device__ __forceinline__ TrTile tr_decode(const Params& P, int it) {
    unsigned char* ws = P.ws; TrTile t; const int l = it / 2816; int i = it % 2816; int kt, nt;
    if (i < 384) { kt = i / 24; nt = i % 24; t.src = P.in[7] + (size_t)l * 1024 * 1536; t.N = 1536; t.K = 1024; t.gain = P.in[6] + l * 1024 + kt * 64; t.dst = (bf16_t*)(ws + OFF_WIN + l * SZ_WIN); t.drow = nt * 64; }
    else if (i < 640) { i -= 384; kt = i / 16; nt = i % 16; t.src = P.in[27] + (size_t)l * 1024 * 1024; t.N = 1024; t.K = 1024;
        t.gain = kt < 8 ? P.in[25] + l * 512 + kt * 64 : P.in[26] + l * 512 + (kt - 8) * 64; t.dst = (bf16_t*)(ws + OFF_WOUT + l * SZ_WOUT); t.drow = nt * 64; }
    else if (i < 2048) { const bool up = i >= 1344; i -= up ? 1344 : 640; kt = i / 44; nt = i % 44; t.src = (up ? P.in[30] : P.in[29]) + (size_t)l * 1024 * 2816; t.N = 2816; t.K = 1024;
        t.gain = P.in[28] + l * 1024 + kt * 64; t.dst = (bf16_t*)(ws + OFF_WGU + l * SZ_WGU); const int f0 = nt * 64; t.drow = (f0 >> 7) * 256 + (f0 & 127) + (up ? 128 : 0); }
    else if (i < 2752) { i -= 2048; kt = i / 16; nt = i % 16; t.src = P.in[31] + (size_t)l * 2816 * 1024; t.N = 1024; t.K = 2816; t.gain = nullptr; t.dst = (bf16_t*)(ws + OFF_WDN + l * SZ_WDN); t.drow = nt * 64; }
    else { i -= 2752; kt = i / 8; nt = i % 8; t.src = P.in[23] + (size_t)l * 512 * 512; t.N = 512; t.K = 512; t.gain = nullptr; t.dst = (bf16_t*)(ws + OFF_WGLU + l * SZ_WGLU); t.drow = nt * 64; }
    t.k0 = kt * 64; t.n0 = nt * 64; return t;
}

__device__ __forceinline__ void convert_range(const Params& P, int count, int base, int split_at, int jump, int rank, int nblk, unsigned char* lds) {
    float* tile = (float*)lds; const int tid = opaque_tid();
    __syncthreads();
    for (int v0 = rank * 4; v0 < count; v0 += nblk * 4) {
        float4 v[4][2]; float gn[4][2];
#pragma unroll
        for (int j = 0; j < 4; ++j) if (v0 + j < count) { const int vv = v0 + j; const TrTile t = tr_decode(P, base + (vv < split_at ? vv : vv + jump));
#pragma unroll
            for (int i = 0; i < 2; ++i) { const int kk = (tid >> 4) + i * 32, nq = tid & 15; v[j][i] = *(const float4*)(t.src + (size_t)(t.k0 + kk) * t.N + t.n0 + nq * 4); gn[j][i] = t.gain ? t.gain[kk] : 1.f; } }
        __syncthreads();
#pragma unroll
        for (int j = 0; j < 4; ++j) if (v0 + j < count) {
#pragma unroll
            for (int i = 0; i < 2; ++i) { const int kk = (tid >> 4) + i * 32, nq = tid & 15; float* tp = tile + j * 4160 + kk * 65 + nq * 4; const float g = gn[j][i];
                tp[0] = v[j][i].x * g; tp[1] = v[j][i].y * g; tp[2] = v[j][i].z * g; tp[3] = v[j][i].w * g; } }
        __syncthreads();
#pragma unroll
        for (int j = 0; j < 4; ++j) if (v0 + j < count) { const int vv = v0 + j; const TrTile t = tr_decode(P, base + (vv < split_at ? vv : vv + jump)); const int n = tid >> 3, kq = tid & 7; const float* tp = tile + j * 4160 + (kq * 8) * 65 + n;
            u32x4 pk; pk[0] = pk_bf16(tp[0], tp[65]); pk[1] = pk_bf16(tp[130], tp[195]); pk[2] = pk_bf16(tp[260], tp[325]); pk[3] = pk_bf16(tp[390], tp[455]);
            *(u32x4*)(t.dst + (size_t)(t.drow + n) * t.K + t.k0 + kq * 8) = pk; }
    }
    __syncthreads();
}
__device__ __forceinline__ void convert_by_idle(const Params& P, int items, int count, int base, int split_at, int jump, unsigned char* lds) {
    const int G = (int)gridDim.x, c = (int)blockIdx.x; const int first = items < G ? items : items % G;
    if (first == 0 || first >= G) convert_range(P, count, base, split_at, jump, c, G, lds);
    else if (c >= first) convert_range(P, count, base, split_at, jump, c - first, G - first, lds);
}

__device__ __forceinline__ void prep_phase(const Params& P, unsigned char* lds) {
    float* tile = (float*)lds; unsigned char* ws = P.ws;
    const int tid = opaque_tid(), wid = tid >> 6, lane = tid & 63;
    const int gtid = blockIdx.x * 512 + tid, gsz = gridDim.x * 512;
    const bool xsplit = (int)gridDim.x >= 256; const int xrows = xsplit ? TP : TT;
    for (int pass = 0; pass < (xsplit ? 2 : 1); ++pass)
    for (int row0 = pass == 0 ? (int)blockIdx.x * 8 + wid : ((int)blockIdx.x >= 128 && (int)blockIdx.x < 144 ? TP + ((int)blockIdx.x - 128) * 8 + wid : TT); row0 < (pass == 0 ? xrows : TT); row0 += (pass == 0 ? gridDim.x * 8 * 4 : 128 * 4)) {
        float4 v[4][4];
#pragma unroll
        for (int q = 0; q < 4; ++q) { const int row = row0 + q * (pass == 0 ? (int)gridDim.x * 8 : 128); if (row < (pass == 0 ? xrows : TT)) { const float* xr = row < TP ? P.in[0] + (size_t)row * 1024 : P.in[1] + (size_t)(row - TP) * 1024;
#pragma unroll
            for (int j = 0; j < 4; ++j) v[q][j] = *(const float4*)(xr + j * 256 + lane * 4); } }
#pragma unroll
        for (int q = 0; q < 4; ++q) { const int row = row0 + q * (pass == 0 ? (int)gridDim.x * 8 : 128); if (row < (pass == 0 ? xrows : TT)) { bf16_t* xb = (bf16_t*)(ws + OFF_XB) + (size_t)row * 1024; float s = 0.f;
#pragma unroll
            for (int j = 0; j < 4; ++j) { const float4 w = v[q][j]; s += w.x * w.x + w.y * w.y + w.z * w.z + w.w * w.w;
                u32x2 pk; pk[0] = pk_bf16(w.x, w.y); pk[1] = pk_bf16(w.z, w.w); *(u32x2*)(xb + j * 256 + lane * 4) = pk; }
#pragma unroll
            for (int o = 1; o < 64; o <<= 1) s += __shfl_xor(s, o);
            if (lane == 0) ((float*)(ws + OFF_SS))[row] = s; } }
    }
    for (int i = gtid; i < 4 * TT; i += gsz) ((float*)(ws + OFF_SS))[TT + i] = 0.f;
    for (int i = gtid; i < 2 * 2 * 8 * 4096; i += gsz) { const int e = i & 4095, hh = (i >> 12) & 7, which = (i >> 15) & 1, l = i >> 16, j = e >> 6, ii = e & 63;
        const float* w = which ? P.in[12] : P.in[10]; ((bf16_t*)(ws + OFF_WAX))[i] = f2bf(w[((size_t)(l * 8 + hh) * 64 + ii) * 64 + j]); }
    for (int i = gtid; i < 4096 * 16; i += gsz) { const int h = i & 15, lgp = i >> 4, l = lgp >> 11, gp = lgp & 2047, g = gp >> 6, p = gp & 63;
        const float lr = P.in[15][lgp], li = P.in[16][lgp], dt = expf(P.in[22][l * 32 + g]);
        const float mag = expf(lr * dt), lbr = mag * cosf(li * dt), lbi = mag * sinf(li * dt);
        const float nr = lbr - 1.f, ni = lbi, den = lr * lr + li * li, gr = (nr * lr + ni * li) / den, gi = (ni * lr - nr * li) / den;
        const float br = P.in[17][(size_t)lgp * 16 + h], bi = P.in[18][(size_t)lgp * 16 + h];
        bf16_t* bb = (bf16_t*)(ws + OFF_BB) + ((size_t)(l * 32 + g) * 128) * 16;
        bb[(size_t)p * 16 + h] = f2bf(gr * br - gi * bi); bb[(size_t)(64 + p) * 16 + h] = f2bf(gr * bi + gi * br);
        bf16_t* cm = (bf16_t*)(ws + OFF_CM) + ((size_t)(l * 32 + g) * 16) * 128;
        cm[h * 128 + 2 * p] = f2bf(P.in[19][((size_t)(l * 32 + g) * 16 + h) * 64 + p]); cm[h * 128 + 2 * p + 1] = f2bf(-P.in[20][((size_t)(l * 32 + g) * 16 + h) * 64 + p]);
        if (h == 0) { float pr = lbr, pi = lbi;
            for (int sq = 0; sq < 5; ++sq) { const float t = pr * pr - pi * pi; pi = 2.f * pr * pi; pr = t; }
            float* lb = (float*)(ws + OFF_LB) + (size_t)l * 4 * 2048; lb[gp] = lbr; lb[2048 + gp] = lbi; lb[4096 + gp] = pr; lb[6144 + gp] = pi; } }
    { const int coff = (int)gridDim.x >= 256 ? 144 : 0;
      if ((int)blockIdx.x >= coff) convert_range(P, 448, 0, 384, 2368, (int)blockIdx.x - coff, (int)gridDim.x - coff, lds); }
}

__device__ __forceinline__ void norm_store(const bf16_t* gtile, bf16_t* dst) {
    const int tid = opaque_tid(), tok = tid >> 4, part = tid & 15; const bf16_t* src = gtile + tok * 520 + part * 32;
    float v[32]; float s = 0.f;
#pragma unroll
    for (int q = 0; q < 4; ++q) { const u32x4 w = *(const u32x4*)(src + q * 8);
#pragma unroll
        for (int e = 0; e < 4; ++e) { const float a = __uint_as_float(w[e] << 16), b = __uint_as_float(w[e] & 0xFFFF0000u); v[q * 8 + e * 2] = a; v[q * 8 + e * 2 + 1] = b; s += a * a + b * b; } }
    s += __shfl_xor(s, 1); s += __shfl_xor(s, 2); s += __shfl_xor(s, 4); s += __shfl_xor(s, 8);
    const float rs = rsqrtf(s * (1.f / 512.f) + EPS);
    bf16_t* d = dst + (size_t)tok * 1024 + part * 32;
#pragma unroll
    for (int q = 0; q < 4; ++q) { u32x4 pk;
#pragma unroll
        for (int e = 0; e < 4; ++e) pk[e] = pk_bf16(v[q * 8 + e * 2] * rs, v[q * 8 + e * 2 + 1] * rs);
        *(u32x4*)(d + q * 8) = pk; }
}

struct S5G { bf16x4 bbf[8]; bf16x8 cmf[4]; bf16x4 uf[2]; bf16x4 df; float lbr, lbi, xr, xi; };
template <bool FINAL>
__device__ __forceinline__ void s5_load(S5G& G, const Params& P, int l, int g, int row0, bool samp, int sb, int tile, int lane) {
    unsigned char* ws = P.ws; const int fr = lane & 15, fq = lane >> 4, p = lane;
    const float* lb = (const float*)(ws + OFF_LB) + (size_t)l * 4 * 2048;
    G.lbr = lb[g * 64 + p]; G.lbi = lb[2048 + g * 64 + p]; G.xr = 0.f; G.xi = 0.f; G.df = (bf16x4){0, 0, 0, 0};
    if (FINAL) { if (samp) { G.xr = P.in[4][((size_t)(l * 8 + sb) * 32 + g) * 64 + p]; G.xi = P.in[5][((size_t)(l * 8 + sb) * 32 + g) * 64 + p]; }
                 else { const float* cc = (const float*)(ws + OFF_S5C) + (size_t)tile * 4096; G.xr = cc[g * 64 + p]; G.xi = cc[2048 + g * 64 + p]; } }
    const bf16_t* bb = (const bf16_t*)(ws + OFF_BB) + ((size_t)(l * 32 + g) * 128) * 16;
#pragma unroll
    for (int nt = 0; nt < 8; ++nt) G.bbf[nt] = *(const bf16x4*)(bb + (size_t)(nt * 16 + fr) * 16 + fq * 4);
    const bf16_t* Z = (const bf16_t*)(ws + OFF_Z);
    if (FINAL) { const bf16_t* cm = (const bf16_t*)(ws + OFF_CM) + ((size_t)(l * 32 + g) * 16 + fr) * 128;
#pragma unroll
        for (int kk = 0; kk < 4; ++kk) G.cmf[kk] = *(const bf16x8*)(cm + kk * 32 + fq * 8);
        { const short dv = (short)f2bf(P.in[21][l * 512 + g * 16 + fr]); G.df[0] = (fq * 4 + 0 == fr) ? dv : (short)0; G.df[1] = (fq * 4 + 1 == fr) ? dv : (short)0; G.df[2] = (fq * 4 + 2 == fr) ? dv : (short)0; G.df[3] = (fq * 4 + 3 == fr) ? dv : (short)0; } }
#pragma unroll
    for (int sub = 0; sub < 2; ++sub) { const bf16_t* zu = Z + (size_t)(row0 + sub * 16) * INW + 1024 + g * 16;
        G.uf[sub] = *(const bf16x4*)(zu + (size_t)fr * INW + fq * 4);
    }
}

__device__ __forceinline__ void lru_final_fast(const Params& P, int l, int tile, int tid) {
    unsigned char* ws = P.ws; const int tok = tid >> 4, part = tid & 15, row = tile * 32 + tok;
    const unsigned* hl = (const unsigned*)(ws + OFF_HL) + (size_t)(row >> 1) * 512 + part * 32; const unsigned* pl = (const unsigned*)(ws + OFF_PL) + (size_t)(row >> 1) * 512 + part * 32;
    const bf16_t* gz = (const bf16_t*)(ws + OFF_Z) + (size_t)row * INW + 512 + part * 32; const float* cc = (const float*)(ws + OFF_LRUC) + (size_t)tile * 512 + part * 32;
    u32x4 hv[8], pv[8], gv[4]; f32x4 cv[8];
#pragma unroll
    for (int q = 0; q < 8; ++q) { hv[q] = *(const u32x4*)(hl + q * 4); pv[q] = *(const u32x4*)(pl + q * 4); cv[q] = *(const f32x4*)(cc + q * 4); }
#pragma unroll
    for (int q = 0; q < 4; ++q) gv[q] = *(const u32x4*)(gz + q * 8);
    const bool odd = row & 1;
    float v[32]; float sq = 0.f;
#pragma unroll
    for (int ci = 0; ci < 32; ++ci) {
        const unsigned hw = hv[ci >> 2][ci & 3], pw = pv[ci >> 2][ci & 3], gw = gv[ci >> 3][(ci >> 1) & 3];
        const float h0 = odd ? __uint_as_float(hw & 0xFFFF0000u) : __uint_as_float(hw << 16), p0 = odd ? __uint_as_float(pw & 0xFFFF0000u) : __uint_as_float(pw << 16),
                    g0 = (ci & 1) ? __uint_as_float(gw & 0xFFFF0000u) : __uint_as_float(gw << 16);
        const float y = (h0 + p0 * cv[ci >> 2][ci & 3]) * gelu_t(g0); v[ci] = y; sq += y * y; }
    sq += __shfl_xor(sq, 1); sq += __shfl_xor(sq, 2); sq += __shfl_xor(sq, 4); sq += __shfl_xor(sq, 8);
    const float rs = rsqrtf(sq * (1.f / 512.f) + EPS);
    bf16_t* d = (bf16_t*)(ws + OFF_MIX) + (size_t)row * 1024 + part * 32;
#pragma unroll
    for (int q = 0; q < 4; ++q) { u32x4 pk;
#pragma unroll
        for (int e = 0; e < 4; ++e) pk[e] = pk_bf16(v[q * 8 + e * 2] * rs, v[q * 8 + e * 2 + 1] * rs);
        *(u32x4*)(d + q * 8) = pk; }
    if (tile == NPT - 1) {
        const int c = tid; const bf16_t* zp = (const bf16_t*)(ws + OFF_Z) + (size_t)(TP - 3) * INW + c; float* oc = P.out + O_CONV_P + (size_t)l * 3 * 512;
        oc[c] = bf2f(zp[0]); oc[512 + c] = bf2f(zp[INW]); oc[1024 + c] = bf2f(zp[2 * INW]);
        P.out[O_LRU_P + (size_t)l * 512 + c] = ((const float*)(ws + OFF_LRUB))[(size_t)tile * 512 + c] + ((const float*)(ws + OFF_LRUA))[(size_t)tile * 512 + c] * ((const float*)(ws + OFF_LRUC))[(size_t)tile * 512 + c];
    }
}

template <bool FINAL, bool FAST = false>
__device__ __forceinline__ void mixer_tile(const Params& P, int l, int tile, unsigned char* lds, const int flags = 3) {
    const int tid = opaque_tid(), wid = tid >> 6, lane = tid & 63, fr = lane & 15, fq = lane >> 4;
    unsigned char* ws = P.ws;
    const bool samp = tile >= NPT; const int sb = tile - NPT;
    const int row0 = samp ? TP + sb * 32 : tile * 32;
    const bool seq_start = samp || tile == 0, seq_end = samp || tile == NPT - 1;
    bf16_t* gtile = (bf16_t*)lds;
    unsigned char* wsc = lds + LDS_GT + wid * LDS_WSC;
    float* regA = (float*)wsc; bf16_t* regB = (bf16_t*)(wsc + LDS_RA);
    const bf16_t* Z = (const bf16_t*)(ws + OFF_Z);
    bf16_t* MIX = (bf16_t*)(ws + OFF_MIX);
    __syncthreads();
    S5G cur;
    if (FAST) { lru_final_fast(P, l, tile, tid); s5_load<FINAL>(cur, P, l, wid * 4, row0, samp, sb, tile, lane); }
    else if (flags & 1) {
        const int c = wid * 64 + lane;
        const bf16_t* zc = Z + (size_t)row0 * INW + c;
        unsigned xraw[16];
#pragma unroll
        for (int t = 0; t < 16; ++t) xraw[t] = (unsigned)zc[(size_t)(2 * t) * INW] | ((unsigned)zc[(size_t)(2 * t + 1) * INW] << 16);
        float x3, x2, x1;
        if (seq_start) { if (samp) { const float* sc = P.in[2] + ((size_t)(l * 8 + sb) * 3) * 512; x3 = sc[c]; x2 = sc[512 + c]; x1 = sc[1024 + c]; } else { x3 = 0.f; x2 = 0.f; x1 = 0.f; } }
        else { const bf16_t* zp = Z + (size_t)(row0 - 3) * INW + c; x3 = bf2f(zp[0]); x2 = bf2f(zp[INW]); x1 = bf2f(zp[2 * INW]); }
        if (FINAL) {
#pragma unroll
            for (int t = 0; t < 32; ++t) gtile[t * 520 + c] = zc[(size_t)t * INW + 512];
        }
        const float* cw = P.in[8] + (size_t)l * 4 * 512; const float cw0 = cw[c], cw1 = cw[512 + c], cw2 = cw[1024 + c], cw3 = cw[1536 + c];
        const float cb = P.in[9][l * 512 + c], ba = P.in[11][l * 512 + c], bx = P.in[13][l * 512 + c];
        const float sp8 = -8.f * log1pf(__expf(-P.in[14][l * 512 + c]));
        float h = 0.f, Pa = 1.f;
        if (FINAL) h = samp ? P.in[3][(size_t)(l * 8 + sb) * 512 + c] : ((const float*)(ws + OFF_LRUC))[(size_t)tile * 512 + c];
        const bf16_t* wa = (const bf16_t*)(ws + OFF_WAX) + ((size_t)(l * 2 + 0) * 8 + wid) * 4096;
        const bf16_t* wx = (const bf16_t*)(ws + OFF_WAX) + ((size_t)(l * 2 + 1) * 8 + wid) * 4096;
        bf16x8 waf[4][2], wxf[4][2];
#pragma unroll
        for (int jt = 0; jt < 4; ++jt)
#pragma unroll
            for (int kk = 0; kk < 2; ++kk) { waf[jt][kk] = *(const bf16x8*)(wa + (jt * 16 + fr) * 64 + kk * 32 + fq * 8); wxf[jt][kk] = *(const bf16x8*)(wx + (jt * 16 + fr) * 64 + kk * 32 + fq * 8); }
        s5_load<FINAL>(cur, P, l, wid * 4, row0, samp, sb, tile, lane);
        bf16_t* xcs = regB; float* pre = regA;
#pragma unroll
        for (int sub = 0; sub < 2; ++sub) {
#pragma unroll
            for (int tt = 0; tt < 16; ++tt) { const float x0 = (tt & 1) ? __uint_as_float(xraw[sub * 8 + (tt >> 1)] & 0xFFFF0000u) : __uint_as_float(xraw[sub * 8 + (tt >> 1)] << 16); const float xc = cb + cw0 * x3 + cw1 * x2 + cw2 * x1 + cw3 * x0; x3 = x2; x2 = x1; x1 = x0; xcs[tt * 72 + lane] = f2bf(xc); }
            WAVE_SYNC();
            f32x4 aa[4], ax[4];
#pragma unroll
            for (int jt = 0; jt < 4; ++jt) { aa[jt] = (f32x4){0.f, 0.f, 0.f, 0.f}; ax[jt] = (f32x4){0.f, 0.f, 0.f, 0.f}; }
#pragma unroll
            for (int kk = 0; kk < 2; ++kk) { const bf16x8 bfv = *(const bf16x8*)(xcs + fr * 72 + kk * 32 + fq * 8);
#pragma unroll
                for (int jt = 0; jt < 4; ++jt) { aa[jt] = __builtin_amdgcn_mfma_f32_16x16x32_bf16(bfv, waf[jt][kk], aa[jt], 0, 0, 0); ax[jt] = __builtin_amdgcn_mfma_f32_16x16x32_bf16(bfv, wxf[jt][kk], ax[jt], 0, 0, 0); } }
#pragma unroll
            for (int jt = 0; jt < 4; ++jt) { *(f32x4*)(pre + (jt * 16 + fr) * 20 + fq * 4) = aa[jt]; *(f32x4*)(pre + 1280 + (jt * 16 + fr) * 20 + fq * 4) = ax[jt]; }
            WAVE_SYNC();
#pragma unroll 2
            for (int q = 0; q < 4; ++q) {
                typedef float f32x2 __attribute__((ext_vector_type(2)));
                const f32x4 pa4 = *(const f32x4*)(pre + lane * 20 + q * 4), px4 = *(const f32x4*)(pre + 1280 + lane * 20 + q * 4);
                const float NL2E = -1.4426950408889634f, sp8l = sp8 * 1.4426950408889634f;
#pragma unroll
                for (int ep = 0; ep < 2; ++ep) { const int tt = q * 4 + 2 * ep;
                    const f32x2 ua = ((f32x2){pa4[2 * ep], pa4[2 * ep + 1]} + (f32x2){ba, ba}) * NL2E, ux = ((f32x2){px4[2 * ep], px4[2 * ep + 1]} + (f32x2){bx, bx}) * NL2E;
                    const f32x2 da = (f32x2){__builtin_amdgcn_exp2f(ua[0]), __builtin_amdgcn_exp2f(ua[1])} + 1.f, dx = (f32x2){__builtin_amdgcn_exp2f(ux[0]), __builtin_amdgcn_exp2f(ux[1])} + 1.f;
                    const f32x2 rg = (f32x2){__builtin_amdgcn_rcpf(da[0]), __builtin_amdgcn_rcpf(da[1])}, ig = (f32x2){__builtin_amdgcn_rcpf(dx[0]), __builtin_amdgcn_rcpf(dx[1])};
                    const f32x2 la = rg * sp8l, av = (f32x2){__builtin_amdgcn_exp2f(la[0]), __builtin_amdgcn_exp2f(la[1])};
                    const f32x2 om = 1.f - av * av;
                    const f32x2 xc = (f32x2){bf2f(xcs[tt * 72 + lane]), bf2f(xcs[(tt + 1) * 72 + lane])};
                    const f32x2 bv = (f32x2){__builtin_amdgcn_sqrtf(fmaxf(om[0], 0.f)), __builtin_amdgcn_sqrtf(fmaxf(om[1], 0.f))} * (ig * xc);
                    const float h0 = av[0] * h + bv[0], p0 = Pa * av[0]; h = av[1] * h0 + bv[1]; Pa = p0 * av[1];
                    if (!FINAL) { ((unsigned*)(ws + OFF_HL))[(size_t)((row0 + sub * 16 + tt) >> 1) * 512 + c] = pk_bf16(h0, h); ((unsigned*)(ws + OFF_PL))[(size_t)((row0 + sub * 16 + tt) >> 1) * 512 + c] = pk_bf16(p0, Pa); }
                    if (FINAL) { bf16_t* gp = gtile + (sub * 16 + tt) * 520 + c; const float gl0 = bf2f(gp[0]), gl1 = bf2f(gp[520]); gp[0] = f2bf(h0 * gelu_t(gl0)); gp[520] = f2bf(h * gelu_t(gl1)); } }
            }
            WAVE_SYNC();
        }
        if (!FINAL) { ((float*)(ws + OFF_LRUA))[(size_t)tile * 512 + c] = Pa; ((float*)(ws + OFF_LRUB))[(size_t)tile * 512 + c] = h; }
        else if (seq_end) {
            float* oc = P.out + (samp ? O_CONV_S + ((size_t)(l * 8 + sb) * 3) * 512 : O_CONV_P + (size_t)l * 3 * 512);
            oc[c] = x3; oc[512 + c] = x2; oc[1024 + c] = x1;
            P.out[(samp ? O_LRU_S + (size_t)(l * 8 + sb) * 512 : O_LRU_P + (size_t)l * 512) + c] = h;
        }
    if (FINAL) { __syncthreads(); norm_store(gtile, MIX + (size_t)row0 * 1024); __syncthreads(); }
    }
    else s5_load<FINAL>(cur, P, l, wid * 4, row0, samp, sb, tile, lane);
    if (flags & 2) {
#pragma unroll
    for (int gi = 0; gi < 4; ++gi) {
        const int g = wid * 4 + gi, p = lane;
        S5G nxt;
        if (gi < 3) s5_load<FINAL>(nxt, P, l, g + 1, row0, samp, sb, tile, lane);
        float xr = cur.xr, xi = cur.xi; const float lbr = cur.lbr, lbi = cur.lbi;
        float* Bu = regA; bf16_t* xs = regB;
#pragma unroll
        for (int sub = 0; sub < 2; ++sub) {
#pragma unroll
            for (int ntp = 0; ntp < 4; ++ntp) {
                const f32x4 dr = __builtin_amdgcn_mfma_f32_16x16x16bf16_1k(cur.uf[sub], cur.bbf[ntp], (f32x4){0.f, 0.f, 0.f, 0.f}, 0, 0, 0);
                const f32x4 di = __builtin_amdgcn_mfma_f32_16x16x16bf16_1k(cur.uf[sub], cur.bbf[ntp + 4], (f32x4){0.f, 0.f, 0.f, 0.f}, 0, 0, 0);
                float* bp = Bu + (ntp * 16 + fr) * 36 + fq * 8;
                *(f32x4*)bp = (f32x4){dr[0], di[0], dr[1], di[1]}; *(f32x4*)(bp + 4) = (f32x4){dr[2], di[2], dr[3], di[3]}; }
            WAVE_SYNC();
            {
                typedef float f32x2 __attribute__((ext_vector_type(2)));
                f32x2 X = (f32x2){xr, xi}; const f32x2 LA = (f32x2){lbr, lbr}, LB = (f32x2){-lbi, lbi};
#pragma unroll
                for (int q = 0; q < 8; ++q) { const f32x4 b4 = *(const f32x4*)(Bu + p * 36 + q * 4);
#pragma unroll
                    for (int e = 0; e < 2; ++e) { const f32x2 bin = (f32x2){b4[2 * e], b4[2 * e + 1]};
                        X = LA * X + (LB * __builtin_shufflevector(X, X, 1, 0) + bin);
                        if (FINAL) ((unsigned*)xs)[(q * 2 + e) * 68 + p] = pk_bf16(X[0], X[1]); } }
                xr = X[0]; xi = X[1];
            }
            if (FINAL) {
                WAVE_SYNC();
                const f32x4 yd = __builtin_amdgcn_mfma_f32_16x16x16bf16_1k(cur.uf[sub], cur.df, (f32x4){0.f, 0.f, 0.f, 0.f}, 0, 0, 0);
                f32x4 y = (f32x4){0.f, 0.f, 0.f, 0.f};
#pragma unroll
                for (int kk = 0; kk < 4; ++kk) { const bf16x8 af = *(const bf16x8*)(xs + fr * 136 + kk * 32 + fq * 8); y = __builtin_amdgcn_mfma_f32_16x16x32_bf16(af, cur.cmf[kk], y, 0, 0, 0); }
#pragma unroll
                for (int r = 0; r < 4; ++r) { const int tok = fq * 4 + r; gtile[(sub * 16 + tok) * 520 + g * 16 + fr] = f2bf(gelu_t(y[r] + yd[r])); }
            }
            WAVE_SYNC();
        }
        if (!FINAL) { float* e = (float*)(ws + OFF_S5E) + (size_t)tile * 4096; e[g * 64 + p] = xr; e[2048 + g * 64 + p] = xi; }
        else if (seq_end) { const size_t o = samp ? ((size_t)(l * 8 + sb) * 32 + g) * 64 + p : ((size_t)l * 32 + g) * 64 + p;
            P.out[(samp ? O_RE_S : O_RE_P) + o] = xr; P.out[(samp ? O_IM_S : O_IM_P) + o] = xi; }
        if (gi < 3) cur = nxt;
    }
    if (FINAL) {
        const bf16_t* wg = (const bf16_t*)(ws + OFF_WGLU + l * SZ_WGLU) + (size_t)(wid * 64 + fr) * 512 + fq * 8;
        bf16x8 bq[2][4][4];
#pragma unroll
        for (int cb = 0; cb < 2; ++cb)
#pragma unroll
            for (int k4 = 0; k4 < 4; ++k4)
#pragma unroll
                for (int nt = 0; nt < 4; ++nt) bq[cb][k4][nt] = *(const bf16x8*)(wg + (size_t)nt * 16 * 512 + (cb * 4 + k4) * 32);
        float bg[4];
#pragma unroll
        for (int nt = 0; nt < 4; ++nt) bg[nt] = P.in[24][l * 512 + wid * 64 + nt * 16 + fr];
        __syncthreads();
        f32x4 acc[2][4];
#pragma unroll
        for (int mt = 0; mt < 2; ++mt)
#pragma unroll
            for (int nt = 0; nt < 4; ++nt) acc[mt][nt] = (f32x4){0.f, 0.f, 0.f, 0.f};
#pragma unroll
        for (int ch = 0; ch < 4; ++ch) {
#pragma unroll
            for (int k4 = 0; k4 < 4; ++k4) { const int kk = ch * 4 + k4;
                bf16x8 af[2];
#pragma unroll
                for (int mt = 0; mt < 2; ++mt) af[mt] = *(const bf16x8*)(gtile + (mt * 16 + fr) * 520 + kk * 32 + fq * 8);
#pragma unroll
                for (int mt = 0; mt < 2; ++mt)
#pragma unroll
                    for (int nt = 0; nt < 4; ++nt) acc[mt][nt] = __builtin_amdgcn_mfma_f32_16x16x32_bf16(af[mt], bq[ch & 1][k4][nt], acc[mt][nt], 0, 0, 0); }
            if (ch < 2) {
#pragma unroll
                for (int k4 = 0; k4 < 4; ++k4)
#pragma unroll
                    for (int nt = 0; nt < 4; ++nt) bq[ch & 1][k4][nt] = *(const bf16x8*)(wg + (size_t)nt * 16 * 512 + ((ch + 2) * 4 + k4) * 32); }
        }
        float o[2][4][4];
#pragma unroll
        for (int mt = 0; mt < 2; ++mt)
#pragma unroll
            for (int nt = 0; nt < 4; ++nt) { const int n = wid * 64 + nt * 16 + fr;
#pragma unroll
                for (int r = 0; r < 4; ++r) o[mt][nt][r] = bf2f(gtile[(mt * 16 + fq * 4 + r) * 520 + n]) * sigm(acc[mt][nt][r] + bg[nt]); }
        __syncthreads();
#pragma unroll
        for (int mt = 0; mt < 2; ++mt)
#pragma unroll
            for (int nt = 0; nt < 4; ++nt)
#pragma unroll
                for (int r = 0; r < 4; ++r) gtile[(mt * 16 + fq * 4 + r) * 520 + wid * 64 + nt * 16 + fr] = f2bf(o[mt][nt][r]);
        __syncthreads();
        norm_store(gtile, MIX + (size_t)row0 * 1024 + 512);
    }
    }
}

__device__ __forceinline__ void carry_phase(const Params& P, int l, unsigned char* lds, const int nitems) {
    unsigned char* ws = P.ws; const int tid = opaque_tid(); const int seg = tid >> 4, ch = tid & 15;
    float* sl = (float*)lds;
    for (int it = blockIdx.x; it < nitems; it += gridDim.x) {
        if (it < 32) {
            const int c = it * 16 + ch; const float* A = (const float*)(ws + OFF_LRUA) + (size_t)(seg * 16) * 512 + c; const float* B = (const float*)(ws + OFF_LRUB) + (size_t)(seg * 16) * 512 + c;
            float a[16], b[16];
#pragma unroll
            for (int k = 0; k < 16; ++k) { a[k] = A[(size_t)k * 512]; b[k] = B[(size_t)k * 512]; }
            float pa = 1.f, pb = 0.f;
#pragma unroll
            for (int k = 0; k < 16; ++k) { pb = a[k] * pb + b[k]; pa *= a[k]; }
            __syncthreads();
            sl[seg * 16 + ch] = pa; sl[512 + seg * 16 + ch] = pb;
            __syncthreads();
            float cs = 0.f;
            for (int s2 = 0; s2 < seg; ++s2) cs = sl[s2 * 16 + ch] * cs + sl[512 + s2 * 16 + ch];
            float* C = (float*)(ws + OFF_LRUC) + (size_t)(seg * 16) * 512 + c;
#pragma unroll
            for (int k = 0; k < 16; ++k) { C[(size_t)k * 512] = cs; cs = a[k] * cs + b[k]; }
        } else if (it < 160) {
            const int idx = (it - 32) * 16 + ch; const float* lb = (const float*)(ws + OFF_LB) + (size_t)l * 4 * 2048; const float qr = lb[4096 + idx], qi = lb[6144 + idx];
            const float* E = (const float*)(ws + OFF_S5E) + (size_t)(seg * 16) * 4096 + idx;
            float er[16], ei[16];
#pragma unroll
            for (int k = 0; k < 16; ++k) { er[k] = E[(size_t)k * 4096]; ei[k] = E[(size_t)k * 4096 + 2048]; }
            float xr = 0.f, xi = 0.f;
#pragma unroll
            for (int k = 0; k < 16; ++k) { const float nr = qr * xr - qi * xi + er[k], ni = qr * xi + qi * xr + ei[k]; xr = nr; xi = ni; }
            float q16r = qr, q16i = qi;
#pragma unroll
            for (int s2 = 0; s2 < 4; ++s2) { const float t = q16r * q16r - q16i * q16i; q16i = 2.f * q16r * q16i; q16r = t; }
            __syncthreads();
            sl[seg * 16 + ch] = xr; sl[512 + seg * 16 + ch] = xi;
            __syncthreads();
            float cr = 0.f, ci = 0.f;
            for (int s2 = 0; s2 < seg; ++s2) { const float nr = q16r * cr - q16i * ci + sl[s2 * 16 + ch], ni = q16r * ci + q16i * cr + sl[512 + s2 * 16 + ch]; cr = nr; ci = ni; }
            float* C = (float*)(ws + OFF_S5C) + (size_t)(seg * 16) * 4096 + idx;
#pragma unroll
            for (int k = 0; k < 16; ++k) { C[(size_t)k * 4096] = cr; C[(size_t)k * 4096 + 2048] = ci; const float nr = qr * cr - qi * ci + er[k], ni = qr * ci + qi * cr + ei[k]; cr = nr; ci = ni; }
        } else mixer_tile<true>(P, l, NPT + ((it - 160) & 7), lds, it < 168 ? 1 : 2);
    }
}

__device__ __forceinline__ void final_norm(const Params& P) {
    const float* ss = (const float*)(P.ws + OFF_SS) + 4 * TT; const int tid = opaque_tid(); const bf16_t* XB = (const bf16_t*)(P.ws + OFF_XB);
    const int cg = (tid & 127) * 8;
    const float4 g0 = *(const float4*)(P.in[32] + cg), g1 = *(const float4*)(P.in[32] + cg + 4);
    for (int r0 = blockIdx.x * 4 + (tid >> 7); r0 < TP; r0 += gridDim.x * 4 * 4) {
        u32x4 w[4]; float rs[4];
#pragma unroll
        for (int j = 0; j < 4; ++j) { const int row = r0 + j * gridDim.x * 4; if (row < TP) { w[j] = *(const u32x4*)(XB + (size_t)row * 1024 + cg); rs[j] = ss[row]; } }
#pragma unroll
        for (int j = 0; j < 4; ++j) { const int row = r0 + j * gridDim.x * 4; if (row < TP) { const float q = rsqrtf(rs[j] * (1.f / 1024.f) + EPS); float4 a, b;
            a.x = __uint_as_float(w[j][0] << 16) * q * g0.x; a.y = __uint_as_float(w[j][0] & 0xFFFF0000u) * q * g0.y; a.z = __uint_as_float(w[j][1] << 16) * q * g0.z; a.w = __uint_as_float(w[j][1] & 0xFFFF0000u) * q * g0.w;
            b.x = __uint_as_float(w[j][2] << 16) * q * g1.x; b.y = __uint_as_float(w[j][2] & 0xFFFF0000u) * q * g1.y; b.z = __uint_as_float(w[j][3] << 16) * q * g1.z; b.w = __uint_as_float(w[j][3] & 0xFFFF0000u) * q * g1.w;
            *(float4*)(P.out + (size_t)row * 1024 + cg) = a; *(float4*)(P.out + (size_t)row * 1024 + cg + 4) = b; } }
    }
    const int wid = tid >> 6, lane = tid & 63;
    for (int r = blockIdx.x + wid * gridDim.x; r < 256; r += gridDim.x * 8) { const bf16_t* xb = XB + (size_t)(TP + r) * 1024; float* xr = P.out + (size_t)(TP + r) * 1024; float4 v[4]; float sq = 0.f;
#pragma unroll
        for (int j = 0; j < 4; ++j) { const u32x2 w = *(const u32x2*)(xb + j * 256 + lane * 4); v[j].x = __uint_as_float(w[0] << 16); v[j].y = __uint_as_float(w[0] & 0xFFFF0000u); v[j].z = __uint_as_float(w[1] << 16); v[j].w = __uint_as_float(w[1] & 0xFFFF0000u); }
        for (int s0 = 0; s0 < 11; s0 += 4) {
            float4 w[4][4];
#pragma unroll
            for (int b = 0; b < 4; ++b) if (s0 + b < 11) { const float* pr = (const float*)(P.ws + OFF_PART) + ((size_t)(s0 + b) * 256 + r) * 1024;
#pragma unroll
                for (int j = 0; j < 4; ++j) w[b][j] = *(const float4*)(pr + j * 256 + lane * 4); }
#pragma unroll
            for (int b = 0; b < 4; ++b) if (s0 + b < 11) {
#pragma unroll
                for (int j = 0; j < 4; ++j) { v[j].x += w[b][j].x; v[j].y += w[b][j].y; v[j].z += w[b][j].z; v[j].w += w[b][j].w; } } }
#pragma unroll
        for (int j = 0; j < 4; ++j) sq += v[j].x * v[j].x + v[j].y * v[j].y + v[j].z * v[j].z + v[j].w * v[j].w;
#pragma unroll
        for (int o = 1; o < 64; o <<= 1) sq += __shfl_xor(sq, o);
        const float rs = rsqrtf(sq * (1.f / 1024.f) + EPS);
#pragma unroll
        for (int j = 0; j < 4; ++j) { const float4 g = *(const float4*)(P.in[32] + j * 256 + lane * 4); v[j].x *= rs * g.x; v[j].y *= rs * g.y; v[j].z *= rs * g.z; v[j].w *= rs * g.w; *(float4*)(xr + j * 256 + lane * 4) = v[j]; } }
}

#define GSYNC() do { XcdBarrier xb_; xb_.bar = (unsigned*)(P.ws + OFF_BAR); xb_.x = (unsigned)__builtin_amdgcn_readfirstlane((int)xb_xcc_id()); xb_.st = (volatile LAS unsigned*)(shm + LDS_XB); xcd_barrier(xb_); } while (0)
__global__ void __launch_bounds__(512, 2) hymba_fwd(Params P) {
    extern __shared__ __attribute__((aligned(16))) unsigned char shm[];
    cg::grid_group grid = cg::this_grid();
    unsigned char* ws = P.ws;
    float* ss = (float*)(ws + OFF_SS);
    bf16_t* XB = (bf16_t*)(ws + OFF_XB);
    unsigned* ctrs = (unsigned*)(ws + OFF_BAR) + CTR_WORD0;
    if (threadIdx.x < 4) ((volatile unsigned*)(shm + LDS_XB))[threadIdx.x] = 0u;
    __syncthreads();
    if (threadIdx.x == 0) (void)xb_add(&((unsigned*)(ws + OFF_BAR))[XB_XCNT((unsigned)__builtin_amdgcn_readfirstlane((int)xb_xcc_id()))], 1u);
    if (P.out == nullptr) grid.sync();
    prep_phase(P, shm);
    GSYNC();
    for (int l = 0; l < 2; ++l) {
        if (l) sample_fix(P, 11, ss + (size_t)(2 * l) * TT, ctrs + 128, 166);
        const int g1_first = (65 * 6) % (int)gridDim.x, g1_idle = (int)gridDim.x - g1_first; const bool early_sample = (65 * 6 > (int)gridDim.x) && g1_idle >= 32 && (int)gridDim.x >= 176;
        run_gemm_g1(shm, XB, (const bf16_t*)(ws + OFF_WIN + l * SZ_WIN), INW, DM, EpiZ{(bf16_t*)(ws + OFF_Z), ss + (size_t)(2 * l) * TT}, l ? ctrs + 128 : nullptr, early_sample ? ctrs + 192 + 64 * l : nullptr);
        if (early_sample) {
            const int rk = (int)blockIdx.x - g1_first;
            if (rk >= 0 && rk < 16) { wait_counter(ctrs + 192 + 64 * l, 6 * 8); mixer_tile<true>(P, l, NPT + (rk & 7), shm, rk < 8 ? 1 : 2); }
            else if (rk >= 16 && l == 0) convert_range(P, 1664, 384, 1664, 0, rk - 16, g1_idle - 16, shm);
        } else if (l == 0) convert_by_idle(P, 65 * 6, 1664, 384, 1664, 0, shm);
        GSYNC();
        for (int t = blockIdx.x; t < NPT; t += gridDim.x) mixer_tile<false>(P, l, t, shm);
        GSYNC();
        carry_phase(P, l, shm, early_sample ? 160 : 176);
        if (early_sample && (int)blockIdx.x >= 160 && (int)blockIdx.x < 176)
            run_gemm_sample_split(shm, (const bf16_t*)(ws + OFF_MIX), (const bf16_t*)(ws + OFF_WOUT + l * SZ_WOUT), DM, DM, 4, (int)blockIdx.x - 160, EpiRes{XB, ss + (size_t)(2 * l + 1) * TT, (float*)(ws + OFF_PART)});
        if (l == 0) convert_by_idle(P, 176, 704, 2048, 704, 0, shm);
        GSYNC();
        for (int t = blockIdx.x; t < NPT; t += gridDim.x) mixer_tile<true, true>(P, l, t, shm);
        GSYNC();
        if (early_sample) run_gemm(shm, (const bf16_t*)(ws + OFF_MIX), (const bf16_t*)(ws + OFF_WOUT + l * SZ_WOUT), TP, DM, DM, EpiRes{XB, ss + (size_t)(2 * l + 1) * TT, (float*)(ws + OFF_PART)}, nullptr);
        else run_gemm_split(shm, (const bf16_t*)(ws + OFF_MIX), (const bf16_t*)(ws + OFF_WOUT + l * SZ_WOUT), DM, DM, 4,
                 EpiRes{XB, ss + (size_t)(2 * l + 1) * TT, (float*)(ws + OFF_PART)});
        GSYNC();
        sample_fix(P, 4, ss + (size_t)(2 * l + 1) * TT, ctrs + 64 * l, 150);
        run_gemm(shm, XB, (const bf16_t*)(ws + OFF_WGU + l * SZ_WGU), TT, NGU, DM, EpiFF{(bf16_t*)(ws + OFF_FF), ss + (size_t)(2 * l + 1) * TT}, ctrs + 64 * l);
        if (l == 0) convert_by_idle(P, 65 * 22, 2112, 2816, 2048, 704, shm);
        GSYNC();
        run_gemm_split(shm, (const bf16_t*)(ws + OFF_FF), (const bf16_t*)(ws + OFF_WDN + l * SZ_WDN), DM, DFF, 11,
                 EpiRes{XB, ss + (size_t)(2 * l + 2) * TT, (float*)(ws + OFF_PART)});
        if (l == 0) convert_by_idle(P, 256 + 44, 704, 2816 + 2048, 704, 0, shm);
        GSYNC();
    }
    final_norm(P);
}

extern "C" void kernel_launch(void* const* d_in, const int* in_sizes, int n_in, void* d_out, int out_size, void* d_ws, size_t ws_size, hipStream_t stream) {
    static int grid = 0;
    if (grid == 0) {
        if (n_in != 33 || ws_size < WS_END) { fprintf(stderr, "kernel_launch: expected 33 inputs and >= %zu bytes of workspace (got %d, %zu)\n", (size_t)WS_END, n_in, ws_size); grid = -1; return; }
        int dev = 0, cus = 0, per_cu = 0;
        hipGetDevice(&dev); hipDeviceGetAttribute(&cus, hipDeviceAttributeMultiprocessorCount, dev);
        if (hipFuncSetAttribute((const void*)hymba_fwd, hipFuncAttributeMaxDynamicSharedMemorySize, LDS_BYTES) != hipSuccess) { fprintf(stderr, "kernel_launch: hipFuncSetAttribute failed\n"); grid = -1; return; }
        if (hipOccupancyMaxActiveBlocksPerMultiprocessor(&per_cu, (const void*)hymba_fwd, 512, LDS_BYTES) != hipSuccess || per_cu < 1) { fprintf(stderr, "kernel_launch: occupancy query gave %d\n", per_cu); per_cu = 1; }
        (void)hipGetLastError();
        grid = cus * per_cu;
    }
    if (grid < 0) return;
    if (hipMemsetAsync((unsigned char*)d_ws + OFF_BAR, 0, 16384, stream) != hipSuccess) { fprintf(stderr, "kernel_launch: memset of the barrier words failed\n"); return; }
    Params p{};
    for (int i = 0; i < 33; ++i) p.in[i] = (const float*)d_in[i];
    p.out = (float*)d_out; p.ws = (unsigned char*)d_ws;
    void* args[] = {&p};
    hipError_t e = hipLaunchCooperativeKernel((const void*)hymba_fwd, dim3(grid), dim3(512), args, LDS_BYTES, stream);
    if (e != hipSuccess) fprintf(stderr, "cooperative launch failed: %s (grid %d)\n", hipGetErrorString(e), grid);
}
```
